# Optimizing an MI355X kernel written in HIP

```python
import jax, jax.numpy as jnp
from jax import lax
import numpy as np

D_MODEL = 2048
BATCH = 32
SEQ = 256
DEPTH = 2
DEC_BATCH = 8
DEC_SEQ = 4096
PAST_LEN = 256

GRID_W = 64
N_MIXERS = 2
HEAD_DIM = 128
N_HEADS = D_MODEL // HEAD_DIM
N_KV_HEADS = 4
GQA_GROUP = N_HEADS // N_KV_HEADS
D_ATTN = N_HEADS * HEAD_DIM
D_KV = N_KV_HEADS * HEAD_DIM
QKV_DIM = D_ATTN + 2 * D_KV
ROPE_THETA = 10000.0
ROPE_AXIS_DIM = HEAD_DIM // 2
Q_BLOCK = 128
POOL_WINDOWS = (2, 4, 8, 16)
N_POOL_GROUPS = 4
POOL_GC = D_MODEL // N_POOL_GROUPS
D_FF = 5632
N_ATTN_LAYERS = (DEPTH + 1) // 2
N_POOL_LAYERS = DEPTH // 2
ALPHA = (2.0 * DEPTH) ** 0.25
BETA = (8.0 * DEPTH) ** -0.25
LN_EPS = 1e-5
QK_EPS = 1e-6
MOD_STD = 0.5

kernel_name = 'hybrid_flow_attn_pool_macaron_step'


def layer_norm(x, g, b):
    xf = x.astype(jnp.float32)
    mu = jnp.mean(xf, axis=-1, keepdims=True)
    var = jnp.mean(jnp.square(xf - mu), axis=-1, keepdims=True)
    y = (xf - mu) * lax.rsqrt(var + LN_EPS) * g.astype(jnp.float32) + b.astype(jnp.float32)
    return y.astype(x.dtype)


def rms_norm(x, g):
    xf = x.astype(jnp.float32)
    y = xf * lax.rsqrt(jnp.mean(jnp.square(xf), axis=-1, keepdims=True) + QK_EPS) * g.astype(jnp.float32)
    return y.astype(x.dtype)


def modulation(cond, w_mod, b_mod):
    m = jax.nn.silu(cond) @ w_mod + b_mod
    return m.reshape(cond.shape[0], 3, 3, D_MODEL)


def modulate(x, shift, scale):
    return x * (1.0 + scale[:, None, :]) + shift[:, None, :]


def post_norm_residual(x, y, gate, g, b, weight):
    return layer_norm(ALPHA * x + weight * gate[:, None, :] * y, g, b)


def ffn_sublayer(x, m, w1, w3, w2, g, b):
    h = modulate(x, m[:, 0], m[:, 1])
    f = (jax.nn.silu(h @ w1) * (h @ w3)) @ w2
    return post_norm_residual(x, f, m[:, 2], g, b, 0.5)


def axial_rope_tables(n_tokens):
    rows = n_tokens // GRID_W
    r, cgrid = jnp.meshgrid(jnp.arange(rows), jnp.arange(GRID_W), indexing='ij')
    row = r.reshape(-1).astype(jnp.float32)
    col = cgrid.reshape(-1).astype(jnp.float32)
    half = ROPE_AXIS_DIM // 2
    freqs = ROPE_THETA ** (-jnp.arange(half, dtype=jnp.float32) / half)
    ang_r = row[:, None] * freqs
    ang_c = col[:, None] * freqs
    return jnp.cos(ang_r), jnp.sin(ang_r), jnp.cos(ang_c), jnp.sin(ang_c)


def rope_half(x, cos, sin):
    x1, x2 = jnp.split(x, 2, axis=-1)
    cos = cos[:, None, :]
    sin = sin[:, None, :]
    return jnp.concatenate([x1 * cos - x2 * sin, x1 * sin + x2 * cos], axis=-1)


def apply_axial_rope(x, tables):
    cr, sr, cc, sc = tables
    xf = x.astype(jnp.float32)
    xr, xc = jnp.split(xf, 2, axis=-1)
    out = jnp.concatenate([rope_half(xr, cr, sr), rope_half(xc, cc, sc)], axis=-1)
    return out.astype(x.dtype)


def qkv_heads(h, w_qkv, q_gain, k_gain):
    bsz, n, _ = h.shape
    qkv = h @ w_qkv
    q = qkv[..., :D_ATTN].reshape(bsz, n, N_HEADS, HEAD_DIM)
    k = qkv[..., D_ATTN:D_ATTN + D_KV].reshape(bsz, n, N_KV_HEADS, HEAD_DIM)
    v = qkv[..., D_ATTN + D_KV:].reshape(bsz, n, N_KV_HEADS, HEAD_DIM)
    return rms_norm(q, q_gain), rms_norm(k, k_gain), v


def block_attention(q, k, v):
    bsz, n = q.shape[0], q.shape[1]
    nb = n // Q_BLOCK
    qb = q.reshape(bsz, nb, Q_BLOCK, N_KV_HEADS, GQA_GROUP, HEAD_DIM)
    qb = jnp.moveaxis(qb, 1, 0)
    scale = HEAD_DIM ** -0.5

    def one_block(qblk):
        s = jnp.einsum('bqkgd,blkd->bkgql', qblk, k, preferred_element_type=jnp.float32) * scale
        p = jax.nn.softmax(s, axis=-1).astype(v.dtype)
        return jnp.einsum('bkgql,blkd->bqkgd', p, v)

    o = lax.map(one_block, qb)
    return jnp.moveaxis(o, 0, 1).reshape(bsz, n, D_ATTN)


def pool_mix(h, w_pool, pool_scale):
    bsz, n, _ = h.shape
    hf = h.astype(jnp.float32)
    csum = jnp.concatenate([jnp.zeros((bsz, 1, D_MODEL), jnp.float32), jnp.cumsum(hf, axis=1)], axis=1)
    t = jnp.arange(n)
    outs = []
    for gi, win in enumerate(POOL_WINDOWS):
        lo = jnp.clip(t - win // 2, 0, n)
        hi = jnp.clip(t + win // 2, 0, n)
        cg = csum[..., gi * POOL_GC:(gi + 1) * POOL_GC]
        count = (hi - lo).astype(jnp.float32)[None, :, None]
        mean = (cg[:, hi] - cg[:, lo]) / count
        outs.append(mean - hf[..., gi * POOL_GC:(gi + 1) * POOL_GC])
    d = jnp.stack(outs, axis=2).astype(h.dtype)
    y = jnp.einsum('bngc,gcd->bngd', d, w_pool).reshape(bsz, n, D_MODEL)
    return y * pool_scale


def setup_inputs(seed: int = 0) -> dict:
    key = jax.random.key(seed)
    ks = jax.random.split(key, 20)
    f32 = jnp.float32

    def nrm(k, shape, std):
        return jax.random.normal(k, shape, f32) * std

    return {
        'x_prompt': nrm(ks[0], (BATCH, SEQ, D_MODEL), 1.0),
        'x_sample': nrm(ks[1], (DEC_BATCH, DEC_SEQ, D_MODEL), 1.0),
        'cache_k': nrm(ks[2], (DEC_BATCH, N_ATTN_LAYERS, PAST_LEN, N_KV_HEADS, HEAD_DIM), 1.0),
        'cache_v': nrm(ks[3], (DEC_BATCH, N_ATTN_LAYERS, PAST_LEN, N_KV_HEADS, HEAD_DIM), 1.0),
        'c': nrm(ks[4], (DEC_BATCH, D_MODEL), 1.0),
        'c_ctx': nrm(ks[5], (D_MODEL,), 1.0),
        'w_mod': nrm(ks[6], (DEPTH, D_MODEL, 9 * D_MODEL), MOD_STD * D_MODEL ** -0.5),
        'b_mod': nrm(ks[7], (DEPTH, 9 * D_MODEL), 0.02),
        'ln_g': 1.0 + nrm(ks[8], (DEPTH, 3, D_MODEL), 0.02),
        'ln_b': nrm(ks[9], (DEPTH, 3, D_MODEL), 0.02),
        'ffn_w1': nrm(ks[10], (DEPTH, 2, D_MODEL, D_FF), D_MODEL ** -0.5),
        'ffn_w3': nrm(ks[11], (DEPTH, 2, D_MODEL, D_FF), D_MODEL ** -0.5),
        'ffn_w2': nrm(ks[12], (DEPTH, 2, D_FF, D_MODEL), BETA * D_FF ** -0.5),
        'w_qkv': nrm(ks[13], (N_ATTN_LAYERS, D_MODEL, QKV_DIM), D_MODEL ** -0.5),
        'q_gain': 1.0 + nrm(ks[14], (N_ATTN_LAYERS, HEAD_DIM), 0.02),
        'k_gain': 1.0 + nrm(ks[15], (N_ATTN_LAYERS, HEAD_DIM), 0.02),
        'w_o': nrm(ks[16], (N_ATTN_LAYERS, D_ATTN, D_MODEL), BETA * D_ATTN ** -0.5),
        'w_pool': nrm(ks[17], (N_POOL_LAYERS, N_POOL_GROUPS, POOL_GC, POOL_GC), BETA * POOL_GC ** -0.5),
        'pool_scale': 1.0 + nrm(ks[18], (N_POOL_LAYERS, D_MODEL), 0.1),
    }


def reference(x_prompt, x_sample, cache_k, cache_v, c, c_ctx, w_mod, b_mod, ln_g, ln_b,
              ffn_w1, ffn_w3, ffn_w2, w_qkv, q_gain, k_gain, w_o, w_pool, pool_scale):
    x = x_prompt
    new_k = []
    new_v = []
    for i in range(DEPTH):
        m = modulation(c_ctx[None, :], w_mod[i], b_mod[i])
        x = ffn_sublayer(x, m[:, 0], ffn_w1[i, 0], ffn_w3[i, 0], ffn_w2[i, 0], ln_g[i, 0], ln_b[i, 0])
        h = modulate(x, m[:, 1, 0], m[:, 1, 1])
        j = i // N_MIXERS
        if i % N_MIXERS == 0:
            q, k, v = qkv_heads(h, w_qkv[j], q_gain[j], k_gain[j])
            y = block_attention(q, k, v) @ w_o[j]
            new_k.append(k)
            new_v.append(v)
        else:
            y = pool_mix(h, w_pool[j], pool_scale[j])
        x = post_norm_residual(x, y, m[:, 1, 2], ln_g[i, 1], ln_b[i, 1], 1.0)
        x = ffn_sublayer(x, m[:, 2], ffn_w1[i, 1], ffn_w3[i, 1], ffn_w2[i, 1], ln_g[i, 2], ln_b[i, 2])
    y_prompt = x
    ctx_k = jnp.stack(new_k, axis=1)
    ctx_v = jnp.stack(new_v, axis=1)

    rope = axial_rope_tables(x_sample.shape[1])
    x = x_sample
    for i in range(DEPTH):
        m = modulation(c, w_mod[i], b_mod[i])
        x = ffn_sublayer(x, m[:, 0], ffn_w1[i, 0], ffn_w3[i, 0], ffn_w2[i, 0], ln_g[i, 0], ln_b[i, 0])
        h = modulate(x, m[:, 1, 0], m[:, 1, 1])
        j = i // N_MIXERS
        if i % N_MIXERS == 0:
            q, k, v = qkv_heads(h, w_qkv[j], q_gain[j], k_gain[j])
            q = apply_axial_rope(q, rope)
            k = apply_axial_rope(k, rope)
            k_all = jnp.concatenate([cache_k[:, j].astype(k.dtype), k], axis=1)
            v_all = jnp.concatenate([cache_v[:, j].astype(v.dtype), v], axis=1)
            y = block_attention(q, k_all, v_all) @ w_o[j]
        else:
            y = pool_mix(h, w_pool[j], pool_scale[j])
        x = post_norm_residual(x, y, m[:, 1, 2], ln_g[i, 1], ln_b[i, 1], 1.0)
        x = ffn_sublayer(x, m[:, 2], ffn_w1[i, 1], ffn_w3[i, 1], ffn_w2[i, 1], ln_g[i, 2], ln_b[i, 2])
    y_sample = x
    return (y_prompt, y_sample, ctx_k, ctx_v)
```

```cpp
#include <hip/hip_runtime.h>
#include <cstdio>
#include <cstdint>

constexpr int D = 2048, FF = 5632, QKVD = 3072, DKV = 512, HD = 128;
constexpr int TC = 8192, TL = 32768, T = TC + TL;
constexpr int CSEQ = 256, LSEQ = 4096, PAST = 256, KVLEN = PAST + LSEQ;
constexpr int NB = 9;
constexpr int MODW = 9 * D;
constexpr float ALPHA = 1.4142135623730951f;
constexpr float LN_EPS = 1e-5f, QK_EPS = 1e-6f;

constexpr size_t MiB = 1u << 20;
constexpr size_t WS_CTL = 0, CTL_ZERO_BYTES = 1 * MiB;
constexpr size_t WS_MOD = 1 * MiB;
constexpr size_t WS_ROPE = 3 * MiB - 65536;
constexpr size_t WS_W13 = 3 * MiB;
constexpr size_t WS_W2 = WS_W13 + 176 * MiB;
constexpr size_t WS_WQKV = WS_W2 + 88 * MiB;
constexpr size_t WS_WO = WS_WQKV + 12 * MiB;
constexpr size_t WS_WPOOL = WS_WO + 8 * MiB;
constexpr size_t WS_H = WS_WPOOL + 2 * MiB;
constexpr size_t WS_Q = WS_H + 160 * MiB;
constexpr size_t WS_G = WS_Q + 160 * MiB;
constexpr size_t WS_QKV = WS_G;
constexpr size_t WS_KALL = WS_G + 240 * MiB;
constexpr size_t WS_VALL = WS_KALL + 34 * MiB;
constexpr size_t WS_KCTX = WS_VALL + 34 * MiB;
constexpr size_t WS_VCTX = WS_KCTX + 8 * MiB;
constexpr size_t WS_DP = WS_G;
constexpr size_t WS_END = WS_G + 440 * MiB;
static_assert(WS_VCTX + 8 * MiB <= WS_END, "ws map");
constexpr int CW_BAR = 4096;

constexpr int RING_BYTES = 131072;
constexpr int MISC_OFF = RING_BYTES + 320;
constexpr int LDS_BYTES = 147456;
constexpr int NWAVES = 8;

#define GAS __attribute__((address_space(1)))
#define LAS __attribute__((address_space(3)))
typedef unsigned short bf16;
typedef unsigned v4u __attribute__((ext_vector_type(4)));
typedef unsigned v2u __attribute__((ext_vector_type(2)));
typedef float f32x4 __attribute__((ext_vector_type(4)));
typedef float f32x2 __attribute__((ext_vector_type(2)));
typedef short bf16x8 __attribute__((ext_vector_type(8)));

__device__ __forceinline__ unsigned cvt_pk_bf16(float lo, float hi) { unsigned r; asm volatile("v_cvt_pk_bf16_f32 %0, %1, %2" : "=v"(r) : "v"(lo), "v"(hi)); return r; }
__device__ __forceinline__ float bf_lo(unsigned w) { return __uint_as_float(w << 16); }
__device__ __forceinline__ float bf_hi(unsigned w) { return __uint_as_float(w & 0xffff0000u); }
__device__ __forceinline__ float wave_sum(float v) {
#pragma unroll
    for (int o = 1; o < 64; o <<= 1) v += __shfl_xor(v, o);
    return v;
}
__device__ __forceinline__ float silu_f(float x) { return x * __builtin_amdgcn_rcpf(1.0f + __builtin_amdgcn_exp2f(-1.4426950408889634f * x)); }
__device__ __forceinline__ int opaque_tid() { int t = threadIdx.x; asm volatile("" : "+v"(t)); return t; }
__device__ __forceinline__ int batch_of_row(int m) { return m < TC ? 0 : 1 + ((m - TC) >> 12); }

namespace pg8 {
#define PG8_LAS __attribute__((address_space(3)))
typedef unsigned short bf16_t;
constexpr int BM = 256, BK = 64, HALF = 128, HTB = HALF * BK * 2, STAGE_BYTES = 8 * HTB, NXCD = 8, WGM = 8;
__host__ __device__ __forceinline__ int lds_byte(int r, int c) { const int st = (r >> 4) * 2 + (c >> 5), rr = r & 15, cc = c & 31, ob = rr * 64 + cc * 2; return st * 1024 + (ob ^ (((ob >> 9) & 1) << 5)); }
__host__ __device__ __forceinline__ void stage_rc(int b, int& R, int& C) { const int st = b / 1024, sb = b % 1024, swz = sb ^ (((sb >> 9) & 1) << 5); R = (st >> 1) * 16 + swz / 64; C = (st & 1) * 32 + (swz % 64) / 2; }
__host__ __device__ __forceinline__ int perm32(int rho) { const int n = rho >> 4, i = rho & 15; return 8 * (i >> 2) + 4 * n + (i & 3); }

struct Unit { int pm, pn; };
struct Gemm { const bf16_t* A; const bf16_t* Bt; int M, N, K, lda, grouped; };

struct StaticOrder {
    int nM, nN, nwg, G, c;
    __device__ void init(int M, int N, int G_, int c_) { nM = M / BM; nN = N / BM; nwg = nM * nN; G = G_; c = c_; }
    __device__ bool next(int i, Unit& u) const {
        const long L = (long)i * G + c; if (L >= nwg) return false;
        int wgid = (int)L; { const int q = nwg / NXCD, r = nwg % NXCD, xcd = wgid % NXCD, off = wgid / NXCD; wgid = (xcd < r ? xcd * (q + 1) : r * (q + 1) + (xcd - r) * q) + off; }
        const int nig = WGM * nN, gid = wgid / nig, fm = gid * WGM, gsz = (nM - fm) < WGM ? (nM - fm) : WGM;
        u.pm = fm + ((wgid % nig) % gsz); u.pn = (wgid % nig) / gsz; return true;
    }
};

struct EpiBf16 {
    static constexpr bool PERM = true;
    bf16_t* O; int ldc;
    __device__ __forceinline__ void operator()(const f32x4 (&acc)[2][2][4][2], const Unit& u, int wr, int wc, int fr, int fq) const {
        const int row0 = u.pm * BM + wr * 64 + fr, col0 = u.pn * BM + wc * 32 + 8 * fq;
#pragma unroll
        for (int ai = 0; ai < 2; ++ai)
#pragma unroll
            for (int m = 0; m < 4; ++m) { bf16_t* rowp = O + (size_t)(row0 + ai * HALF + m * 16) * ldc + col0;
#pragma unroll
                for (int bj = 0; bj < 2; ++bj) { const f32x4 v0 = acc[ai][bj][m][0], v1 = acc[ai][bj][m][1];
                    v4u w; w.x = cvt_pk_bf16(v0[0], v0[1]); w.y = cvt_pk_bf16(v0[2], v0[3]); w.z = cvt_pk_bf16(v1[0], v1[1]); w.w = cvt_pk_bf16(v1[2], v1[3]);
                    *(v4u*)(rowp + bj * HALF) = w; } }
    }
};
struct EpiSwiGLU {
    static constexpr bool PERM = true;
    bf16_t* O; int ldc;
    __device__ __forceinline__ void operator()(const f32x4 (&acc)[2][2][4][2], const Unit& u, int wr, int wc, int fr, int fq) const {
        const int row0 = u.pm * BM + wr * 64 + fr, col0 = u.pn * HALF + wc * 32 + 8 * fq;
#pragma unroll
        for (int ai = 0; ai < 2; ++ai)
#pragma unroll
            for (int m = 0; m < 4; ++m) { bf16_t* rowp = O + (size_t)(row0 + ai * HALF + m * 16) * ldc + col0;
                const f32x4 a0 = acc[ai][0][m][0], a1 = acc[ai][0][m][1], b0 = acc[ai][1][m][0], b1 = acc[ai][1][m][1];
                float g[8];
#pragma unroll
                for (int j = 0; j < 4; ++j) { g[j] = silu_f(a0[j]) * b0[j]; g[4 + j] = silu_f(a1[j]) * b1[j]; }
                v4u w; w.x = cvt_pk_bf16(g[0], g[1]); w.y = cvt_pk_bf16(g[2], g[3]); w.z = cvt_pk_bf16(g[4], g[5]); w.w = cvt_pk_bf16(g[6], g[7]);
                *(v4u*)rowp = w; }
    }
};
struct EpiResid {
    static constexpr bool PERM = false;
    float* X; int ldc; const float* gate0; int gstride; float wgt; const float* pscale;
    __device__ __forceinline__ void operator()(const f32x4 (&acc)[2][2][4][2], const Unit& u, int wr, int wc, int fr, int fq) const {
        const int row0 = u.pm * BM + wr * 64 + fr, col0 = u.pn * BM + wc * 32 + 4 * fq;
        const int bi = batch_of_row(u.pm * BM);
        const float* gv = gate0 + (size_t)bi * gstride;
        f32x4 cf[2][2];
#pragma unroll
        for (int bj = 0; bj < 2; ++bj)
#pragma unroll
            for (int n = 0; n < 2; ++n) { f32x4 g = *(const f32x4*)(gv + col0 + bj * HALF + n * 16) * wgt;
                if (pscale) g = g * *(const f32x4*)(pscale + col0 + bj * HALF + n * 16);
                cf[bj][n] = g; }
#pragma unroll
        for (int ai = 0; ai < 2; ++ai)
#pragma unroll
            for (int m = 0; m < 4; ++m) { float* rowp = X + (size_t)(row0 + ai * HALF + m * 16) * ldc + col0;
#pragma unroll
                for (int bj = 0; bj < 2; ++bj)
#pragma unroll
                    for (int n = 0; n < 2; ++n) { f32x4* p = (f32x4*)(rowp + bj * HALF + n * 16); *p = *p * ALPHA + cf[bj][n] * acc[ai][bj][m][n]; } }
    }
};

template <class Epi>
__device__ __forceinline__ void gemm_phase(PG8_LAS unsigned char* lds, const Gemm g, const StaticOrder& S, const Epi& E) {
    const int tid = opaque_tid(), wid = __builtin_amdgcn_readfirstlane(tid >> 6), lane = tid & 63, wr = wid >> 2, wc = wid & 3, fr = lane & 15, fq = lane >> 4;
    const int K = g.K, nt = K / BK, lda = g.lda;
    unsigned voffA[2], voffB[2];
#pragma unroll
    for (int i = 0; i < 2; ++i) { int R, C; stage_rc(tid * 16 + i * 8192, R, C); const int Rb = Epi::PERM ? ((R & ~31) + perm32(R & 31)) : R;
        voffA[i] = (unsigned)(R * lda + C) * 2u; voffB[i] = (unsigned)(Rb * K + C) * 2u; }
    const size_t kstep = (size_t)(BK * 2);
    const size_t hstepA = (size_t)HALF * lda * 2, hstepB = (size_t)HALF * K * 2;
    const size_t tstepA = 2 * hstepA, tstepB = 2 * hstepB;
    const unsigned ldsw = (unsigned)wid * 1024u;
    const int aoff = lds_byte(wr * 64 + fr, fq * 8), boff = lds_byte(wc * 32 + fr, fq * 8);
#define PG8_SA(b, h) (((b) * 2 + (h)) * HTB)
#define PG8_SB(b, h) ((4 + (b) * 2 + (h)) * HTB)
#define PG8_STAGE(bufoff, gbase, voff) do { _Pragma("unroll") for (int _i = 0; _i < 2; ++_i) \
        __builtin_amdgcn_global_load_lds((const unsigned*)((const char*)(gbase) + (voff)[_i]), (PG8_LAS unsigned*)(lds + (bufoff) + ldsw + _i * 8192), 16, 0, 0); } while (0)
#define PG8_LDA(dst, b, h) do { _Pragma("unroll") for (int m = 0; m < 4; ++m) _Pragma("unroll") for (int k = 0; k < 2; ++k) dst[m][k] = *(const PG8_LAS bf16x8*)(lds + PG8_SA(b, h) + aoff + m * 2048 + k * 1024); } while (0)
#define PG8_LDB(dst, b, h) do { _Pragma("unroll") for (int n = 0; n < 2; ++n) _Pragma("unroll") for (int k = 0; k < 2; ++k) dst[n][k] = *(const PG8_LAS bf16x8*)(lds + PG8_SB(b, h) + boff + n * 2048 + k * 1024); } while (0)
#define PG8_MMA(ai, bj, At, Bt) do { __builtin_amdgcn_s_setprio(1); _Pragma("unroll") for (int m = 0; m < 4; ++m) _Pragma("unroll") for (int n = 0; n < 2; ++n) _Pragma("unroll") for (int k = 0; k < 2; ++k) \
        acc[ai][bj][m][n] = __builtin_amdgcn_mfma_f32_16x16x32_bf16(Bt[n][k], At[m][k], acc[ai][bj][m][n], 0, 0, 0); __builtin_amdgcn_s_setprio(0); } while (0)
#define PG8_WAIT_V(n) asm volatile("s_waitcnt vmcnt(" #n ")" ::: "memory")
#define PG8_WAIT_L(n) asm volatile("s_waitcnt lgkmcnt(" #n ")" ::: "memory")
#define PG8_BAR __builtin_amdgcn_s_barrier()
#define PG8_SCHED __builtin_amdgcn_sched_barrier(0)
    Unit cur, nxt; int ui = 0;
    if (!S.next(0, cur)) return;
    f32x4 acc[2][2][4][2];
#pragma unroll
    for (int a = 0; a < 2; ++a)
#pragma unroll
        for (int b = 0; b < 2; ++b)
#pragma unroll
            for (int m = 0; m < 4; ++m)
#pragma unroll
                for (int n = 0; n < 2; ++n) acc[a][b][m][n] = (f32x4){0.f, 0.f, 0.f, 0.f};
    bf16x8 At[4][2], B0[2][2], B1[2][2];
    const size_t gk = g.grouped ? (size_t)K * 2 : 0;
    const char* cA = (const char*)g.A + (size_t)cur.pm * tstepA + (size_t)(cur.pn >> 1) * gk; const char* cB = (const char*)g.Bt + (size_t)cur.pn * tstepB;
    PG8_STAGE(PG8_SB(0, 0), cB, voffB); PG8_STAGE(PG8_SB(0, 1), cB + hstepB, voffB); PG8_STAGE(PG8_SA(0, 0), cA, voffA); PG8_STAGE(PG8_SA(0, 1), cA + hstepA, voffA);
    if (wr == 1) PG8_BAR;
    PG8_WAIT_V(2); PG8_BAR;
    PG8_STAGE(PG8_SB(1, 0), cB + kstep, voffB); PG8_STAGE(PG8_SA(1, 0), cA + kstep, voffA); PG8_STAGE(PG8_SB(1, 1), cB + hstepB + kstep, voffB);
    PG8_WAIT_V(6); PG8_BAR;
    for (;;) {
        const bool has_next = S.next(ui + 1, nxt);
        const char* nA = has_next ? (const char*)g.A + (size_t)nxt.pm * tstepA + (size_t)(nxt.pn >> 1) * gk : cA; const char* nB = has_next ? (const char*)g.Bt + (size_t)nxt.pn * tstepB : cB;
        for (int t = 0; t < nt; t += 2) {
            const bool last = (t == nt - 2);
            const char* a1 = cA + (size_t)(t + 1) * kstep;
            const char* a2 = last ? nA : cA + (size_t)(t + 2) * kstep; const char* b2 = last ? nB : cB + (size_t)(t + 2) * kstep;
            const char* a3 = a2 + kstep; const char* b3 = b2 + kstep;
            PG8_LDB(B0, 0, 0); PG8_LDB(B1, 0, 1); PG8_SCHED; PG8_LDA(At, 0, 0); PG8_STAGE(PG8_SA(1, 1), a1 + hstepA, voffA);
            PG8_WAIT_V(8); PG8_WAIT_L(0); PG8_BAR; PG8_MMA(0, 0, At, B0); PG8_MMA(0, 1, At, B1); PG8_BAR; PG8_SCHED;
            PG8_LDA(At, 0, 1); PG8_STAGE(PG8_SB(0, 0), b2, voffB); PG8_STAGE(PG8_SB(0, 1), b2 + hstepB, voffB); PG8_STAGE(PG8_SA(0, 0), a2, voffA);
            PG8_WAIT_V(8); PG8_WAIT_L(0); PG8_BAR; PG8_MMA(1, 0, At, B0); PG8_MMA(1, 1, At, B1); PG8_BAR; PG8_SCHED;
            PG8_LDB(B0, 1, 0); PG8_LDB(B1, 1, 1); PG8_SCHED; PG8_LDA(At, 1, 0); PG8_STAGE(PG8_SA(0, 1), a2 + hstepA, voffA);
            PG8_WAIT_V(8); PG8_WAIT_L(0); PG8_BAR; PG8_MMA(0, 0, At, B0); PG8_MMA(0, 1, At, B1); PG8_BAR; PG8_SCHED;
            PG8_LDA(At, 1, 1); PG8_STAGE(PG8_SB(1, 0), b3, voffB); PG8_STAGE(PG8_SB(1, 1), b3 + hstepB, voffB); PG8_STAGE(PG8_SA(1, 0), a3, voffA);
            PG8_WAIT_V(8); PG8_WAIT_L(0); PG8_BAR; PG8_MMA(1, 0, At, B0); PG8_MMA(1, 1, At, B1); PG8_BAR; PG8_SCHED;
        }
        if (wr == 0) PG8_BAR;
        E(acc, cur, wr, wc, fr, fq);
        if (!has_next) break;
#pragma unroll
        for (int a = 0; a < 2; ++a)
#pragma unroll
            for (int b = 0; b < 2; ++b)
#pragma unroll
                for (int m = 0; m < 4; ++m)
#pragma unroll
                    for (int n = 0; n < 2; ++n) acc[a][b][m][n] = (f32x4){0.f, 0.f, 0.f, 0.f};
        cur = nxt; cA = nA; cB = nB; ++ui;
        if (wr == 1) PG8_BAR;
    }
    PG8_WAIT_V(0);
    PG8_BAR;
#undef PG8_SA
#undef PG8_SB
#undef PG8_STAGE
#undef PG8_LDA
#undef PG8_LDB
#undef PG8_MMA
#undef PG8_WAIT_V
#undef PG8_WAIT_L
#undef PG8_BAR
#undef PG8_SCHED
}
}

namespace att {
constexpr int NW = 8, QBLK = 32, KVBLK = 64;
constexpr float SCALE = 0.088388347648318440f;
constexpr float THR = 8.f;
constexpr int LDQ = D, LDK = DKV, LDO = D;
constexpr size_t SHM_V = KVBLK * HD * 2, SHM_K = KVBLK * HD * 2, SHM_ATTN = 2 * SHM_V + 2 * SHM_K + NW * 64 * 4;
using s16x4 = __attribute__((ext_vector_type(4))) short;
using f32x16 = __attribute__((ext_vector_type(16))) float;
using u32x4 = __attribute__((ext_vector_type(4))) unsigned;
#define KSWZ(row, colB) ((row) * 256 + ((colB) ^ (((row) & 7) << 4)))
#define SBAR() __builtin_amdgcn_sched_barrier(0)
__device__ __forceinline__ int crow(int r, int hi) { return (r & 3) + 8 * (r >> 2) + 4 * hi; }
__device__ __forceinline__ unsigned cvtpk(float lo, float hi) { unsigned r; asm volatile("v_cvt_pk_bf16_f32 %0, %1, %2" : "=v"(r) : "v"(lo), "v"(hi)); return r; }

__device__ __forceinline__ void partialSM(f32x16& p0, f32x16& p1, float& m_reg, float& mn, float& alpha) {
  constexpr float C = SCALE * 1.4426950408889634f;
  float pmax = p0[0]; for (int r = 1; r < 16; ++r) pmax = fmaxf(pmax, p0[r]); for (int r = 0; r < 16; ++r) pmax = fmaxf(pmax, p1[r]);
  { auto rr = __builtin_amdgcn_permlane32_swap(__float_as_uint(pmax), __float_as_uint(pmax), false, false);
    pmax = fmaxf(__uint_as_float(rr[0]), __uint_as_float(rr[1])); }
  if (__builtin_expect(__all(pmax - m_reg <= THR / SCALE), 1)) { mn = m_reg; alpha = 1.f; }
  else { mn = fmaxf(m_reg, pmax); alpha = __builtin_amdgcn_exp2f((m_reg - mn) * C); m_reg = mn; }
  float mnC = -mn * C;
  for (int r = 0; r < 16; ++r) p0[r] = fmaf(p0[r], C, mnC); for (int r = 0; r < 16; ++r) p1[r] = fmaf(p1[r], C, mnC);
  for (int r = 0; r < 16; ++r) p0[r] = __builtin_amdgcn_exp2f(p0[r]);
}
__device__ __forceinline__ void finishSM(f32x16& p0, f32x16& p1, float alpha, float& l_reg, bf16x8& pa0, bf16x8& pa1, bf16x8& pa2, bf16x8& pa3) {
  for (int r = 0; r < 16; ++r) p1[r] = __builtin_amdgcn_exp2f(p1[r]);
  float ps = 0; for (int r = 0; r < 16; ++r) ps += p0[r]; for (int r = 0; r < 16; ++r) ps += p1[r];
  { auto rr = __builtin_amdgcn_permlane32_swap(__float_as_uint(ps), __float_as_uint(ps), false, false);
    ps = __uint_as_float(rr[0]) + __uint_as_float(rr[1]); }
  l_reg = l_reg * alpha + ps;
#define PK4(P, BASE, OUT) do { unsigned a0 = cvtpk(P[BASE + 0], P[BASE + 1]), a1 = cvtpk(P[BASE + 2], P[BASE + 3]);   \
    unsigned b0 = cvtpk(P[BASE + 4], P[BASE + 5]), b1 = cvtpk(P[BASE + 6], P[BASE + 7]);                              \
    auto r0 = __builtin_amdgcn_permlane32_swap(a0, b0, false, false); auto r1 = __builtin_amdgcn_permlane32_swap(a1, b1, false, false); \
    u32x4 w = {r0[0], r1[0], r0[1], r1[1]}; OUT = *reinterpret_cast<bf16x8*>(&w); } while (0)
  PK4(p0, 0, pa0); PK4(p0, 8, pa1); PK4(p1, 0, pa2); PK4(p1, 8, pa3);
#undef PK4
}
__device__ __forceinline__ void qkt(f32x16& p0, f32x16& p1, const bf16* Ks, const bf16x8* qr, int r32, int hi) {
  p0 = f32x16{}; p1 = f32x16{};
  for (int d0 = 0; d0 < 8; ++d0) { int cb = (d0 * 16 + hi * 8) * 2;
    bf16x8 b0 = *reinterpret_cast<const bf16x8*>((const char*)Ks + KSWZ(r32, cb));
    bf16x8 b1 = *reinterpret_cast<const bf16x8*>((const char*)Ks + KSWZ(32 + r32, cb));
    p0 = __builtin_amdgcn_mfma_f32_32x32x16_bf16(b0, qr[d0], p0, 0, 0, 0);
    p1 = __builtin_amdgcn_mfma_f32_32x32x16_bf16(b1, qr[d0], p1, 0, 0, 0); }
}
__device__ __forceinline__ int v_st(int k, int c) { const int kk = (k & ~0xC) | ((k & 4) << 1) | ((k & 8) >> 1); return ((kk >> 3) * 4 + (c >> 5)) * 512 + ((kk & 7) * 32 + (c & 31)) * 2; }
__device__ __forceinline__ int v_rd_base(int lane) { return ((lane & 3) << 3) | (((lane >> 2) & 3) << 6) | (((lane >> 4) & 1) << 5) | (((lane >> 5) & 1) << 8); }
constexpr int v_rd_off(int d0, int ks, int half) { return d0 * 512 + ks * 4096 + half * 2048; }
template <int OFF> __device__ __forceinline__ s16x4 tr_read(int vb) {
  s16x4 r; asm volatile("ds_read_b64_tr_b16 %0, %1 offset:%2" : "=&v"(r) : "v"(vb), "i"(OFF) : "memory"); return r;
}
template <int D0> __device__ __forceinline__ void pv_one(f32x16& od, int vb, bf16x8 pa0, bf16x8 pa1, bf16x8 pa2, bf16x8 pa3) {
  const s16x4 l0 = tr_read<v_rd_off(D0, 0, 0)>(vb), h0 = tr_read<v_rd_off(D0, 0, 1)>(vb), l1 = tr_read<v_rd_off(D0, 1, 0)>(vb), h1 = tr_read<v_rd_off(D0, 1, 1)>(vb);
  const s16x4 l2 = tr_read<v_rd_off(D0, 2, 0)>(vb), h2 = tr_read<v_rd_off(D0, 2, 1)>(vb), l3 = tr_read<v_rd_off(D0, 3, 0)>(vb), h3 = tr_read<v_rd_off(D0, 3, 1)>(vb);
  asm volatile("s_waitcnt lgkmcnt(0)" ::: "memory"); SBAR();
#define PK(L, H) (bf16x8){L[0], L[1], L[2], L[3], H[0], H[1], H[2], H[3]}
  od = __builtin_amdgcn_mfma_f32_32x32x16_bf16(pa0, PK(l0, h0), od, 0, 0, 0);
  od = __builtin_amdgcn_mfma_f32_32x32x16_bf16(pa1, PK(l1, h1), od, 0, 0, 0);
  od = __builtin_amdgcn_mfma_f32_32x32x16_bf16(pa2, PK(l2, h2), od, 0, 0, 0);
  od = __builtin_amdgcn_mfma_f32_32x32x16_bf16(pa3, PK(l3, h3), od, 0, 0, 0);
#undef PK
}
__device__ __forceinline__ void pv_d0(f32x16* o, int vb, bf16x8 pa0, bf16x8 pa1, bf16x8 pa2, bf16x8 pa3) {
  pv_one<0>(o[0], vb, pa0, pa1, pa2, pa3); pv_one<1>(o[1], vb, pa0, pa1, pa2, pa3); pv_one<2>(o[2], vb, pa0, pa1, pa2, pa3); pv_one<3>(o[3], vb, pa0, pa1, pa2, pa3);
}
__device__ __forceinline__ void attn_dense_body(const bf16* __restrict__ Qb, const bf16* __restrict__ Kh, const bf16* __restrict__ Vh, bf16* Ob, int seq, char* lds) {
  const int tid = opaque_tid(), wid = tid >> 6, lane = tid & 63, r32 = lane & 31, hi = lane >> 5;
  bf16* V_lds = (bf16*)lds; bf16* K_lds = (bf16*)(lds + 2 * SHM_V);
  float* ws = (float*)(lds + 2 * SHM_V + 2 * SHM_K) + wid * 64; float* li_l = ws; float* al_l = ws + 32;
  float m_reg = -1e30f, l_reg = 0; f32x16 o[4] = {}; bf16x8 qr[8];
  const bf16* Qw = Qb + (long)(wid * QBLK + r32) * LDQ + hi * 8;
#pragma unroll
  for (int d0 = 0; d0 < 8; ++d0) qr[d0] = *reinterpret_cast<const bf16x8*>(Qw + d0 * 16);
  const int sr = tid >> 4, sc = (tid & 15) * 8, vst0 = v_st(sr, sc), vst1 = v_st(32 + sr, sc);
  const int vb0 = (int)(uintptr_t)V_lds + v_rd_base(lane);
  struct { bf16x8 vs0, vs1, ks0, ks1; } sr_[2];
#define SLOAD(i, k0) do { sr_[i].vs0 = *reinterpret_cast<const bf16x8*>(&Vh[(long)((k0) + sr) * LDK + sc]); sr_[i].vs1 = *reinterpret_cast<const bf16x8*>(&Vh[(long)((k0) + 32 + sr) * LDK + sc]); \
    sr_[i].ks0 = *reinterpret_cast<const bf16x8*>(&Kh[(long)((k0) + sr) * LDK + sc]); sr_[i].ks1 = *reinterpret_cast<const bf16x8*>(&Kh[(long)((k0) + 32 + sr) * LDK + sc]); } while (0)
#define SWRITE(b, i) do { *(bf16x8*)((char*)V_lds + (b) * SHM_V + vst0) = sr_[i].vs0;          \
    *(bf16x8*)((char*)V_lds + (b) * SHM_V + vst1) = sr_[i].vs1; int kc = sc * 2;               \
    *(bf16x8*)((char*)K_lds + (b) * SHM_K + KSWZ(sr, kc)) = sr_[i].ks0;                       \
    *(bf16x8*)((char*)K_lds + (b) * SHM_K + KSWZ(32 + sr, kc)) = sr_[i].ks1; } while (0)
#define SWAIT() asm volatile("s_waitcnt vmcnt(4)" ::: "memory")
#define RESC(a) do { if (__any((a) < 1.f)) { if (hi == 0) al_l[r32] = (a); asm volatile("s_waitcnt lgkmcnt(0)" ::: "memory"); \
    for (int d = 0; d < 4; ++d) for (int r = 0; r < 16; ++r) o[d][r] *= al_l[crow(r, hi)]; } } while (0)
  f32x16 pA0, pA1, pB0, pB1; float mnA, mnB, alA, alB; bf16x8 pa0, pa1, pa2, pa3; const int NT = seq / KVBLK;
  constexpr int SE = 0, SO = 1;
  SLOAD(SE, 0); asm volatile("s_waitcnt vmcnt(0)" ::: "memory"); SWRITE(0, SE); __syncthreads();
  qkt(pA0, pA1, K_lds, qr, r32, hi); partialSM(pA0, pA1, m_reg, mnA, alA);
  SLOAD(SO, KVBLK); if (2 < NT) SLOAD(SE, 2 * KVBLK);
  SWAIT(); SWRITE(1, SO); __syncthreads();
  for (int j = 1; j + 1 < NT; j += 2) {
    SBAR(); qkt(pB0, pB1, (bf16*)((char*)K_lds + SHM_K), qr, r32, hi);
    finishSM(pA0, pA1, alA, l_reg, pa0, pa1, pa2, pa3); SBAR();
    SLOAD(SO, (j + 2) * KVBLK); SBAR();
    pv_d0(o, vb0, pa0, pa1, pa2, pa3); partialSM(pB0, pB1, m_reg, mnB, alB);
    __syncthreads(); SWAIT(); SWRITE(0, SE);
    RESC(alB); __syncthreads();
    SBAR(); qkt(pA0, pA1, K_lds, qr, r32, hi);
    finishSM(pB0, pB1, alB, l_reg, pa0, pa1, pa2, pa3); SBAR();
    if (j + 3 < NT) SLOAD(SE, (j + 3) * KVBLK); SBAR();
    pv_d0(o, vb0 + (int)SHM_V, pa0, pa1, pa2, pa3); partialSM(pA0, pA1, m_reg, mnA, alA);
    __syncthreads(); SWAIT(); SWRITE(1, SO);
    RESC(alA); __syncthreads();
  }
  SBAR(); qkt(pB0, pB1, (bf16*)((char*)K_lds + SHM_K), qr, r32, hi);
  finishSM(pA0, pA1, alA, l_reg, pa0, pa1, pa2, pa3); SBAR();
  pv_d0(o, vb0, pa0, pa1, pa2, pa3); partialSM(pB0, pB1, m_reg, mnB, alB);
  __syncthreads(); RESC(alB);
  finishSM(pB0, pB1, alB, l_reg, pa0, pa1, pa2, pa3); SBAR();
  pv_d0(o, vb0 + (int)SHM_V, pa0, pa1, pa2, pa3);
  if (hi == 0) li_l[r32] = l_reg; asm volatile("s_waitcnt lgkmcnt(0)" ::: "memory");
  float rli[16];
#pragma unroll
  for (int r = 0; r < 16; ++r) rli[r] = __builtin_amdgcn_rcpf(li_l[crow(r, hi)]);
  bf16* Ow = Ob + (long)(wid * QBLK) * LDO;
#pragma unroll
  for (int r = 0; r < 16; ++r) { int orow = crow(r, hi);
    for (int d0 = 0; d0 < 4; ++d0) Ow[(long)orow * LDO + d0 * 32 + r32] = (bf16)(cvtpk(o[d0][r] * rli[r], 0.f) & 0xffffu); }
#undef SLOAD
#undef SWRITE
#undef SWAIT
#undef RESC
}
}

#define XB_TMO      128
#define XB_XCNT(j)  (256  + 64 * (j))
#define XB_XSUB(j)  (1280 + 64 * (j))
#define XB_XGEN(j)  (2304 + 64 * (j))
#define XB_TOP      3328
#define XB_TOPGEN   3392
#define XCD_BAR_WORDS 3456
#define XB_SPIN_CAP (1u << 20)
__device__ __forceinline__ unsigned xb_ld(unsigned* p)              { return __hip_atomic_load(p, __ATOMIC_RELAXED, __HIP_MEMORY_SCOPE_AGENT); }
__device__ __forceinline__ unsigned xb_add(unsigned* p, unsigned v) { return __hip_atomic_fetch_add(p, v, __ATOMIC_RELAXED, __HIP_MEMORY_SCOPE_AGENT); }
__device__ __forceinline__ unsigned xb_xcc_id() { return (unsigned)__builtin_amdgcn_s_getreg((3 << 11) | 20) & 0xFu; }
#define XB_SPIN(cond, bar) do { unsigned _sp = 0; while (cond) { __builtin_amdgcn_s_sleep(1); \
    if ((++_sp & 255u) == 0u) { if (xb_ld(&(bar)[XB_TMO])) break; if (_sp > XB_SPIN_CAP) { atomicAdd(&(bar)[XB_TMO], 1u); break; } } } } while (0)
struct XcdBarrier { unsigned* bar; unsigned x; volatile LAS unsigned* st; };
__device__ __forceinline__ XcdBarrier xcd_barrier_post(unsigned* bar, volatile LAS unsigned* st) {
    XcdBarrier b; b.bar = bar; b.x = xb_xcc_id(); b.st = st;
    if (threadIdx.x == 0) (void)xb_add(&bar[XB_XCNT(b.x)], 1u);
    return b;
}
__device__ __forceinline__ void xcd_barrier_complete(unsigned* bar, unsigned x, unsigned& nloc, unsigned& nx) {
    const unsigned G = gridDim.x * gridDim.y * gridDim.z;
    unsigned sum, cnt, mine, sp = 0u;
    for (;;) {
        sum = 0u; cnt = 0u; mine = 0u;
#pragma unroll
        for (unsigned j = 0; j < 16; ++j) { const unsigned c = xb_ld(&bar[XB_XCNT(j)]); sum += c; cnt += (c > 0u) ? 1u : 0u; mine = (j == x) ? c : mine; }
        if (sum == G) break;
        __builtin_amdgcn_s_sleep(1);
        if ((++sp & 255u) == 0u) { if (xb_ld(&bar[XB_TMO])) break; if (sp > XB_SPIN_CAP) { atomicAdd(&bar[XB_TMO], 1u); break; } }
    }
    nloc = mine > 0u ? mine : 1u; nx = cnt > 0u ? cnt : 1u;
}
__device__ __forceinline__ void xcd_barrier(const XcdBarrier& b) {
    asm volatile("s_waitcnt vmcnt(0)" ::: "memory");
    __syncthreads();
    if (threadIdx.x == 0) {
        unsigned* bar = b.bar;
        __builtin_amdgcn_s_waitcnt(0);
        unsigned nloc = b.st[0], nx = b.st[1];
        if (nloc == 0u) { xcd_barrier_complete(bar, b.x, nloc, nx); b.st[0] = nloc; b.st[1] = nx; }
        const unsigned old = xb_add(&bar[XB_XSUB(b.x)], 1u);
        const unsigned gen = old / nloc;
        if (old + 1u == (gen + 1u) * nloc) {
            __builtin_amdgcn_fence(__ATOMIC_RELEASE, "agent");
            asm volatile("s_waitcnt vmcnt(0)" ::: "memory");
            const unsigned og = xb_add(&bar[XB_TOP], 1u);
            const unsigned tg = og / nx;
            if (og + 1u == (tg + 1u) * nx) xb_add(&bar[XB_TOPGEN], 1u);
            else XB_SPIN(xb_ld(&bar[XB_TOPGEN]) == tg, bar);
            __builtin_amdgcn_fence(__ATOMIC_ACQUIRE, "agent");
            xb_add(&bar[XB_XGEN(b.x)], 1u);
            asm volatile("s_waitcnt vmcnt(0)" ::: "memory");
        } else {
            XB_SPIN(xb_ld(&bar[XB_XGEN(b.x)]) == gen, bar);
            __builtin_amdgcn_fence(__ATOMIC_ACQUIRE, "agent");
            asm volatile("s_waitcnt vmcnt(0)" ::: "memory");
        }
    }
    __syncthreads();
}

struct Args { const float* in[19]; float* out; unsigned char* ws; };
struct Frame {
    unsigned char* lds; int tid, lane, wave, vcu, G;
    const float *x_prompt, *x_sample, *cache_k, *cache_v, *c, *c_ctx, *w_mod, *b_mod, *ln_g, *ln_b, *w1, *w3, *w2, *w_qkv, *q_gain, *k_gain, *w_o, *w_pool, *pool_scale;
    float* X; float* ctxk; float* ctxv;
    float* mod; float* rope;
    bf16 *W13, *W2, *Wqkv, *Wo, *Wpool, *H, *Q, *Gb, *QKV, *KALL, *VALL, *KCTX, *VCTX, *DP;
};
#define LDS_WAIT() asm volatile("s_waitcnt lgkmcnt(0)" ::: "memory")

__device__ __forceinline__ void transpose_item(const float* W, int K, int N, bf16* WT, int k0, int n0, int drow0, float* scr, int lane) {
#pragma unroll 8
    for (int i = 0; i < 32; ++i) { const int kk = 2 * i + (lane >> 5); scr[kk * 33 + (lane & 31)] = W[(size_t)(k0 + kk) * N + n0 + (lane & 31)]; }
    LDS_WAIT(); asm volatile("" ::: "memory");
    const int c = lane & 7;
#pragma unroll
    for (int j = 0; j < 4; ++j) { const int n = (lane >> 3) + 8 * j; const float* s = scr + (8 * c) * 33 + n;
        v4u o; o.x = cvt_pk_bf16(s[0 * 33], s[1 * 33]); o.y = cvt_pk_bf16(s[2 * 33], s[3 * 33]); o.z = cvt_pk_bf16(s[4 * 33], s[5 * 33]); o.w = cvt_pk_bf16(s[6 * 33], s[7 * 33]);
        *(v4u*)(WT + (size_t)(drow0 + n) * K + k0 + 8 * c) = o; }
    LDS_WAIT(); asm volatile("" ::: "memory");
}

__device__ __forceinline__ void sincos_small(double a, double& s, double& c) {
    const double n = __builtin_rint(a * 0.63661977236758134308);
    const double r = (a - n * 1.5707963267948966192) - n * 6.123233995736766036e-17;
    const double r2 = r * r;
    double sp = -1.0 / 1307674368000.0; sp = sp * r2 + 1.0 / 6227020800.0; sp = sp * r2 - 1.0 / 39916800.0; sp = sp * r2 + 1.0 / 362880.0; sp = sp * r2 - 1.0 / 5040.0; sp = sp * r2 + 1.0 / 120.0; sp = sp * r2 - 1.0 / 6.0; sp = sp * r2 + 1.0; sp = sp * r;
    double cp = 1.0 / 20922789888000.0; cp = cp * r2 - 1.0 / 87178291200.0; cp = cp * r2 + 1.0 / 479001600.0; cp = cp * r2 - 1.0 / 3628800.0; cp = cp * r2 + 1.0 / 40320.0; cp = cp * r2 - 1.0 / 720.0; cp = cp * r2 + 1.0 / 24.0; cp = cp * r2 - 0.5; cp = cp * r2 + 1.0;
    const int q = ((int)n) & 3;
    s = (q == 0) ? sp : (q == 1) ? cp : (q == 2) ? -sp : -cp;
    c = (q == 0) ? cp : (q == 1) ? -sp : (q == 2) ? -cp : sp;
}

__device__ __forceinline__ void p0_prologue(Frame& F0) {
    Frame F = F0; F.tid = opaque_tid(); F.lane = F.tid & 63;
    float* sc = (float*)F.lds;
    float* part = (float*)(F.lds + 73728);
    for (int i = F.tid; i < NB * D; i += 512) { const int bi = i >> 11, k = i & 2047; const float v = bi == 0 ? F.c_ctx[k] : F.c[(bi - 1) * D + k]; sc[i] = v / (1.0f + __expf(-v)); }
    __syncthreads();
    for (int u = F.vcu; u < 2 * 72; u += F.G) {
        const int l = u / 72, cb = u % 72;
        const float* W = F.w_mod + (size_t)l * D * MODW + cb * 256 + F.lane * 4;
        f32x4 acc[NB];
#pragma unroll
        for (int bi = 0; bi < NB; ++bi) acc[bi] = (f32x4){0.f, 0.f, 0.f, 0.f};
        const int kb = F.wave * 256;
#pragma unroll 8
        for (int kk = 0; kk < 256; ++kk) { const f32x4 w = *(const f32x4*)(W + (size_t)(kb + kk) * MODW);
#pragma unroll
            for (int bi = 0; bi < NB; ++bi) acc[bi] += w * sc[bi * D + kb + kk]; }
        if (F.wave >= 4) {
#pragma unroll
            for (int bi = 0; bi < NB; ++bi) *(f32x4*)(part + ((F.wave - 4) * NB + bi) * 256 + F.lane * 4) = acc[bi];
        }
        __syncthreads();
        if (F.wave < 4) {
#pragma unroll
            for (int bi = 0; bi < NB; ++bi) acc[bi] += *(const f32x4*)(part + (F.wave * NB + bi) * 256 + F.lane * 4);
        }
        __syncthreads();
        if (F.wave < 4) {
#pragma unroll
            for (int bi = 0; bi < NB; ++bi) *(f32x4*)(part + (F.wave * NB + bi) * 256 + F.lane * 4) = acc[bi];
        }
        __syncthreads();
        for (int idx = F.tid; idx < NB * 256; idx += 512) { const int bi = idx >> 8, cc = idx & 255;
            float s = F.b_mod[l * MODW + cb * 256 + cc];
#pragma unroll
            for (int w = 0; w < 4; ++w) s += part[(w * NB + bi) * 256 + cc];
            F.mod[((size_t)l * NB + bi) * MODW + cb * 256 + cc] = s; }
        __syncthreads();
    }
    __syncthreads();
    float* scr = (float*)(F.lds + F.wave * 16384);
    const int gw = F.vcu * NWAVES + F.wave, NGW = F.G * NWAVES;
    constexpr int I13 = (D / 64) * (FF / 32), I2 = (FF / 64) * (D / 32), IQ = (D / 64) * (QKVD / 32), IO = (D / 64) * (D / 32), IP = (512 / 64) * (512 / 32);
    constexpr int NITEMS = 8 * I13 + 4 * I2 + IQ + IO + 4 * IP;
    for (int it = gw; it < NITEMS; it += NGW) {
        int r = it;
        if (r < 8 * I13) { const int which = r / (4 * I13); r -= which * 4 * I13; const int mat = r / I13, q = r % I13, kbk = q / (FF / 32), nb = q % (FF / 32), n0 = nb * 32;
            transpose_item((which ? F.w3 : F.w1) + (size_t)mat * D * FF, D, FF, F.W13 + (size_t)mat * 2 * FF * D, kbk * 64, n0, 256 * (n0 >> 7) + (n0 & 127) + which * 128, scr, F.lane); continue; }
        r -= 8 * I13;
        if (r < 4 * I2) { const int mat = r / I2, q = r % I2, kbk = q / (D / 32), nb = q % (D / 32);
            transpose_item(F.w2 + (size_t)mat * FF * D, FF, D, F.W2 + (size_t)mat * D * FF, kbk * 64, nb * 32, nb * 32, scr, F.lane); continue; }
        r -= 4 * I2;
        if (r < IQ) { const int kbk = r / (QKVD / 32), nb = r % (QKVD / 32); transpose_item(F.w_qkv, D, QKVD, F.Wqkv, kbk * 64, nb * 32, nb * 32, scr, F.lane); continue; }
        r -= IQ;
        if (r < IO) { const int kbk = r / (D / 32), nb = r % (D / 32); transpose_item(F.w_o, D, D, F.Wo, kbk * 64, nb * 32, nb * 32, scr, F.lane); continue; }
        r -= IO;
        { const int grp = r / IP, q = r % IP, kbk = q / 16, nb = q % 16; transpose_item(F.w_pool + (size_t)grp * 512 * 512, 512, 512, F.Wpool + (size_t)grp * 512 * 512, kbk * 64, nb * 32, nb * 32, scr, F.lane); }
    }
    for (int i8 = F.vcu * 512 + F.tid; i8 < 8 * PAST * DKV / 8; i8 += F.G * 512) {
        const int e = i8 * 8, b = e / (PAST * DKV), rem = e % (PAST * DKV);
        const f32x4 k0 = *(const f32x4*)(F.cache_k + e), k1 = *(const f32x4*)(F.cache_k + e + 4), v0 = *(const f32x4*)(F.cache_v + e), v1 = *(const f32x4*)(F.cache_v + e + 4);
        v4u kw, vw; kw.x = cvt_pk_bf16(k0[0], k0[1]); kw.y = cvt_pk_bf16(k0[2], k0[3]); kw.z = cvt_pk_bf16(k1[0], k1[1]); kw.w = cvt_pk_bf16(k1[2], k1[3]);
        vw.x = cvt_pk_bf16(v0[0], v0[1]); vw.y = cvt_pk_bf16(v0[2], v0[3]); vw.z = cvt_pk_bf16(v1[0], v1[1]); vw.w = cvt_pk_bf16(v1[2], v1[3]);
        *(v4u*)(F.KALL + (size_t)b * KVLEN * DKV + rem) = kw; *(v4u*)(F.VALL + (size_t)b * KVLEN * DKV + rem) = vw;
    }
    { const int gid = F.vcu * 512 + F.tid;
      if (gid < 2048) { const int pos = gid >> 5, i = gid & 31; const double freq = exp(-(double)i * (9.210340371976182736 / 32.0)); double s, c; sincos_small((double)pos * freq, s, c);
          F.rope[gid] = (float)c; F.rope[2048 + gid] = (float)s; } }
}

template <int MODE, bool WRITE_H>
__device__ __forceinline__ void row_phase(Frame& F0, const float* lng, const float* lnb, const float* modv  ) {
    Frame F = F0; F.tid = opaque_tid(); F.lane = F.tid & 63;
    const int gw = F.vcu * NWAVES + F.wave, NGW = F.G * NWAVES;
    const int per = (T + NGW - 1) / NGW;
    f32x4 gv[8], bv[8], sh[8], sc1[8];
    if (MODE == 1) {
#pragma unroll
        for (int j = 0; j < 8; ++j) { gv[j] = *(const f32x4*)(lng + 256 * j + 4 * F.lane); bv[j] = *(const f32x4*)(lnb + 256 * j + 4 * F.lane); }
    }
    int cur_bi = -1;
    for (int m = gw * per; m < (gw + 1) * per && m < T; ++m) {
        const int bi = batch_of_row(m);
        if (WRITE_H && bi != cur_bi) { cur_bi = bi; const float* mv = modv + (size_t)bi * MODW;
#pragma unroll
            for (int j = 0; j < 8; ++j) { sh[j] = *(const f32x4*)(mv + 256 * j + 4 * F.lane); sc1[j] = *(const f32x4*)(mv + D + 256 * j + 4 * F.lane) + 1.0f; } }
        const float* src = MODE == 0 ? (m < TC ? F.x_prompt + (size_t)m * D : F.x_sample + (size_t)(m - TC) * D) : F.X + (size_t)m * D;
        f32x4 v[8];
#pragma unroll
        for (int j = 0; j < 8; ++j) v[j] = *(const f32x4*)(src + 256 * j + 4 * F.lane);
        if (MODE == 1) {
            float s = 0.f;
#pragma unroll
            for (int j = 0; j < 8; ++j) s += (v[j].x + v[j].y) + (v[j].z + v[j].w);
            const float mean = wave_sum(s) * (1.f / D); float s2 = 0.f;
#pragma unroll
            for (int j = 0; j < 8; ++j) { v[j] = v[j] - mean; s2 += (v[j].x * v[j].x + v[j].y * v[j].y) + (v[j].z * v[j].z + v[j].w * v[j].w); }
            const float rstd = 1.f / sqrtf(wave_sum(s2) * (1.f / D) + LN_EPS);
#pragma unroll
            for (int j = 0; j < 8; ++j) v[j] = v[j] * rstd * gv[j] + bv[j];
        }
        float* xo = F.X + (size_t)m * D;
#pragma unroll
        for (int j = 0; j < 8; ++j) *(f32x4*)(xo + 256 * j + 4 * F.lane) = v[j];
        if (WRITE_H) {
            bf16* ho = F.H + (size_t)m * D;
#pragma unroll
            for (int j = 0; j < 8; ++j) { const f32x4 h = v[j] * sc1[j] + sh[j]; v2u w; w.x = cvt_pk_bf16(h.x, h.y); w.y = cvt_pk_bf16(h.z, h.w); *(v2u*)(ho + 256 * j + 4 * F.lane) = w; }
        }
    }
}

__device__ __forceinline__ void qkv_post(Frame& F0) {
    Frame F = F0; F.tid = opaque_tid(); F.lane = F.tid & 63;
    const int gw = F.vcu * NWAVES + F.wave, NGW = F.G * NWAVES;
    const int c16 = F.lane & 15, hq = F.lane >> 4;
    f32x4 qg0 = *(const f32x4*)(F.q_gain + 8 * c16), qg1 = *(const f32x4*)(F.q_gain + 8 * c16 + 4), kg0 = *(const f32x4*)(F.k_gain + 8 * c16), kg1 = *(const f32x4*)(F.k_gain + 8 * c16 + 4);
    const float qg[8] = {qg0.x, qg0.y, qg0.z, qg0.w, qg1.x, qg1.y, qg1.z, qg1.w}, kg[8] = {kg0.x, kg0.y, kg0.z, kg0.w, kg1.x, kg1.y, kg1.z, kg1.w};
    for (int m = gw; m < T; m += NGW) {
        const bf16* src = F.QKV + (size_t)m * QKVD;
        v4u raw[6];
#pragma unroll
        for (int j = 0; j < 6; ++j) raw[j] = *(const v4u*)(src + (F.lane + 64 * j) * 8);
        const bool lat = m >= TC;
        float cs[8], sn[8];
        int b = 0, p = 0;
        if (lat) { b = (m - TC) >> 12; p = (m - TC) & 4095; const int pos = (c16 < 8) ? (p >> 6) : (p & 63); const float* rc = F.rope + pos * 32 + 8 * (c16 & 3);
            const f32x4 c0 = *(const f32x4*)rc, c1 = *(const f32x4*)(rc + 4), s0 = *(const f32x4*)(rc + 2048), s1 = *(const f32x4*)(rc + 2048 + 4);
            cs[0] = c0.x; cs[1] = c0.y; cs[2] = c0.z; cs[3] = c0.w; cs[4] = c1.x; cs[5] = c1.y; cs[6] = c1.z; cs[7] = c1.w;
            sn[0] = s0.x; sn[1] = s0.y; sn[2] = s0.z; sn[3] = s0.w; sn[4] = s1.x; sn[5] = s1.y; sn[6] = s1.z; sn[7] = s1.w; }
        const bool second = (c16 & 4) != 0;
#pragma unroll
        for (int j = 0; j < 6; ++j) {
            float x[8] = {bf_lo(raw[j].x), bf_hi(raw[j].x), bf_lo(raw[j].y), bf_hi(raw[j].y), bf_lo(raw[j].z), bf_hi(raw[j].z), bf_lo(raw[j].w), bf_hi(raw[j].w)};
            if (j < 5) {
                float ss = 0.f;
#pragma unroll
                for (int e = 0; e < 8; ++e) ss += x[e] * x[e];
                ss += __shfl_xor(ss, 1); ss += __shfl_xor(ss, 2); ss += __shfl_xor(ss, 4); ss += __shfl_xor(ss, 8);
                const float rinv = 1.0f / sqrtf(ss * (1.0f / HD) + QK_EPS);
#pragma unroll
                for (int e = 0; e < 8; ++e) x[e] = x[e] * rinv * (j < 4 ? qg[e] : kg[e]);
                if (lat) {
#pragma unroll
                    for (int e = 0; e < 8; ++e) { const float o = __shfl_xor(x[e], 4); x[e] = second ? (o * sn[e] + x[e] * cs[e]) : (x[e] * cs[e] - o * sn[e]); }
                }
            }
            v4u w; w.x = cvt_pk_bf16(x[0], x[1]); w.y = cvt_pk_bf16(x[2], x[3]); w.z = cvt_pk_bf16(x[4], x[5]); w.w = cvt_pk_bf16(x[6], x[7]);
            if (j < 4) { *(v4u*)(F.Q + (size_t)m * D + (4 * j + hq) * HD + 8 * c16) = w; }
            else {
                const int col = hq * HD + 8 * c16;
                if (lat) { bf16* dst = (j == 4 ? F.KALL : F.VALL) + ((size_t)b * KVLEN + PAST + p) * DKV + col; *(v4u*)dst = w; }
                else { bf16* dst = (j == 4 ? F.KCTX : F.VCTX) + (size_t)m * DKV + col; *(v4u*)dst = w;
                    float* fo = (j == 4 ? F.ctxk : F.ctxv) + (size_t)m * DKV + col;
                    *(f32x4*)fo = (f32x4){x[0], x[1], x[2], x[3]}; *(f32x4*)(fo + 4) = (f32x4){x[4], x[5], x[6], x[7]}; }
            }
        }
    }
}

__device__ __forceinline__ void pool_phase(Frame& F0, const float* modv  ) {
    Frame F = F0; F.tid = opaque_tid(); F.lane = F.tid & 63;
    const int gw = F.vcu * NWAVES + F.wave, NGW = F.G * NWAVES;
    const int per = (T + NGW - 1) / NGW;
    f32x4 sc1[8]; int cur_bi = -1;
    for (int m = gw * per; m < (gw + 1) * per && m < T; ++m) {
        const int bi = batch_of_row(m);
        if (bi != cur_bi) { cur_bi = bi; const float* mv = modv + (size_t)bi * MODW + D;
#pragma unroll
            for (int j = 0; j < 8; ++j) sc1[j] = *(const f32x4*)(mv + 256 * j + 4 * F.lane) + 1.0f; }
        int s0, n;
        if (m < TC) { s0 = m & ~(CSEQ - 1); n = CSEQ; } else { s0 = TC + ((m - TC) & ~(LSEQ - 1)); n = LSEQ; }
        const int t = m - s0;
        bf16* dp = F.DP + (size_t)m * D;
#pragma unroll
        for (int j = 0; j < 8; ++j) {
            const int half = 1 << (j >> 1);
            const int lo = t - half < 0 ? 0 : t - half, hi = t + half > n ? n : t + half;
            f32x4 acc = (f32x4){0.f, 0.f, 0.f, 0.f};
            for (int r = lo; r < hi; ++r) acc += *(const f32x4*)(F.X + (size_t)(s0 + r) * D + 256 * j + 4 * F.lane);
            const f32x4 self = *(const f32x4*)(F.X + (size_t)m * D + 256 * j + 4 * F.lane);
            const f32x4 d = (acc * (1.0f / (float)(hi - lo)) - self) * sc1[j];
            v2u w; w.x = cvt_pk_bf16(d.x, d.y); w.y = cvt_pk_bf16(d.z, d.w); *(v2u*)(dp + 256 * j + 4 * F.lane) = w;
        }
    }
}

__global__ void __launch_bounds__(NWAVES * 64, 2) fwd_kernel(Args args) {
    extern __shared__ __attribute__((aligned(16))) unsigned char lds[];
    Frame F;
    F.lds = lds; F.tid = threadIdx.x; F.lane = F.tid & 63; F.wave = __builtin_amdgcn_readfirstlane(F.tid >> 6);
    F.G = gridDim.x; { const int bx = blockIdx.x; F.vcu = (F.G % 8 == 0) ? (bx % 8) * (F.G / 8) + bx / 8 : bx; }
    F.x_prompt = args.in[0]; F.x_sample = args.in[1]; F.cache_k = args.in[2]; F.cache_v = args.in[3]; F.c = args.in[4]; F.c_ctx = args.in[5]; F.w_mod = args.in[6]; F.b_mod = args.in[7];
    F.ln_g = args.in[8]; F.ln_b = args.in[9]; F.w1 = args.in[10]; F.w3 = args.in[11]; F.w2 = args.in[12]; F.w_qkv = args.in[13]; F.q_gain = args.in[14]; F.k_gain = args.in[15];
    F.w_o = args.in[16]; F.w_pool = args.in[17]; F.pool_scale = args.in[18];
    F.X = args.out; F.ctxk = args.out + (size_t)T * D; F.ctxv = F.ctxk + (size_t)TC * DKV;
    unsigned char* ws = args.ws;
    F.mod = (float*)(ws + WS_MOD); F.rope = (float*)(ws + WS_ROPE);
    F.W13 = (bf16*)(ws + WS_W13); F.W2 = (bf16*)(ws + WS_W2); F.Wqkv = (bf16*)(ws + WS_WQKV); F.Wo = (bf16*)(ws + WS_WO); F.Wpool = (bf16*)(ws + WS_WPOOL);
    F.H = (bf16*)(ws + WS_H); F.Q = (bf16*)(ws + WS_Q); F.Gb = (bf16*)(ws + WS_G); F.QKV = (bf16*)(ws + WS_QKV);
    F.KALL = (bf16*)(ws + WS_KALL); F.VALL = (bf16*)(ws + WS_VALL); F.KCTX = (bf16*)(ws + WS_KCTX); F.VCTX = (bf16*)(ws + WS_VCTX); F.DP = (bf16*)(ws + WS_DP);
    volatile LAS unsigned* MISC = (volatile LAS unsigned*)((LAS unsigned char*)lds + MISC_OFF);
    for (int u = F.tid; u < 32; u += NWAVES * 64) MISC[u] = 0u;
    __syncthreads();
    XcdBarrier bar = xcd_barrier_post((unsigned*)(ws + WS_CTL) + CW_BAR, MISC + 8);
    PG8_LAS unsigned char* ring = (PG8_LAS unsigned char*)lds;

    p0_prologue(F);
    xcd_barrier(bar);
    row_phase<0, true>(F, nullptr, nullptr, F.mod);
    xcd_barrier(bar);

    for (int l = 0; l < 2; ++l) {
        const float* modl = F.mod + (size_t)l * NB * MODW;
        for (int s = 0; s < 2; ++s) {
            const int f = l * 2 + s, sub = s * 2;
            { pg8::Gemm g{F.H, F.W13 + (size_t)f * 2 * FF * D, T, 2 * FF, D, D, 0}; pg8::StaticOrder S; S.init(T, 2 * FF, F.G, (int)blockIdx.x);
              pg8::EpiSwiGLU E{F.Gb, FF};
              pg8::gemm_phase<pg8::EpiSwiGLU>(ring, g, S, E); }
            xcd_barrier(bar);
            { pg8::Gemm g{F.Gb, F.W2 + (size_t)f * D * FF, T, D, FF, FF, 0}; pg8::StaticOrder S; S.init(T, D, F.G, (int)blockIdx.x);
              pg8::EpiResid E{F.X, D, modl + (sub * 3 + 2) * D, MODW, 0.5f, nullptr};
              pg8::gemm_phase<pg8::EpiResid>(ring, g, S, E); }
            xcd_barrier(bar);
            { const float* lng = F.ln_g + (size_t)(l * 3 + sub) * D; const float* lnb = F.ln_b + (size_t)(l * 3 + sub) * D;
              if (s == 0) { if (l == 0) row_phase<1, true>(F, lng, lnb, modl + (1 * 3) * D); else row_phase<1, false>(F, lng, lnb, nullptr); }
              else { if (l == 0) row_phase<1, true>(F, lng, lnb, F.mod + (size_t)NB * MODW); else row_phase<1, false>(F, lng, lnb, nullptr); } }
            xcd_barrier(bar);
            if (s == 0) {
                if (l == 0) {
                    { pg8::Gemm g{F.H, F.Wqkv, T, QKVD, D, D, 0}; pg8::StaticOrder S; S.init(T, QKVD, F.G, (int)blockIdx.x);
                      pg8::EpiBf16 E{F.QKV, QKVD};
                      pg8::gemm_phase<pg8::EpiBf16>(ring, g, S, E); }
                    xcd_barrier(bar);
                    qkv_post(F);
                    xcd_barrier(bar);
                    { const int x = F.vcu >> 5, cc = F.vcu & 31;
                      for (int i = 0; i < 8; ++i) {
                          const int pair = x * 4 + (i >> 1), uu = (i & 1) * 32 + cc, b = pair >> 2, kvh = pair & 3, h = kvh * 4 + (uu >> 4), qb = uu & 15;
                          const size_t qoff = ((size_t)TC + (size_t)b * LSEQ + (size_t)qb * 256) * D + h * HD;
                          att::attn_dense_body(F.Q + qoff, F.KALL + (size_t)b * KVLEN * DKV + kvh * HD, F.VALL + (size_t)b * KVLEN * DKV + kvh * HD, F.Q + qoff, KVLEN, (char*)lds);
                          __syncthreads(); }
                      for (int i = 0; i < 2; ++i) {
                          const int uu = i * 32 + cc, pair = x * 16 + (uu >> 2), b = pair >> 2, kvh = pair & 3, h = kvh * 4 + (uu & 3);
                          const size_t qoff = (size_t)b * CSEQ * D + h * HD;
                          att::attn_dense_body(F.Q + qoff, F.KCTX + (size_t)b * CSEQ * DKV + kvh * HD, F.VCTX + (size_t)b * CSEQ * DKV + kvh * HD, F.Q + qoff, CSEQ, (char*)lds);
                          __syncthreads(); } }
                    xcd_barrier(bar);
                    { pg8::Gemm g{F.Q, F.Wo, T, D, D, D, 0}; pg8::StaticOrder S; S.init(T, D, F.G, (int)blockIdx.x);
                      pg8::EpiResid E{F.X, D, modl + (1 * 3 + 2) * D, MODW, 1.0f, nullptr};
                      pg8::gemm_phase<pg8::EpiResid>(ring, g, S, E); }
                    xcd_barrier(bar);
                } else {
                    pool_phase(F, modl + (1 * 3) * D);
                    xcd_barrier(bar);
                    { pg8::Gemm g{F.DP, F.Wpool, T, D, 512, D, 1}; pg8::StaticOrder S; S.init(T, D, F.G, (int)blockIdx.x);
                      pg8::EpiResid E{F.X, D, modl + (1 * 3 + 2) * D, MODW, 1.0f, F.pool_scale};
                      pg8::gemm_phase<pg8::EpiResid>(ring, g, S, E); }
                    xcd_barrier(bar);
                }
                row_phase<1, true>(F, F.ln_g + (size_t)(l * 3 + 1) * D, F.ln_b + (size_t)(l * 3 + 1) * D, modl + (2 * 3) * D);
                xcd_barrier(bar);
            }
        }
    }
}

extern "C" void kernel_launch(void* const* d_in, const int* in_sizes, int n_in, void* d_out, int out_size, void* d_ws, size_t ws_size, hipStream_t stream) {
    static int grid = 0;
    if (grid == 0) {
        if (n_in != 19 || ws_size < WS_END) { fprintf(stderr, "kernel_launch: n_in %d ws %zu (need %zu)\n", n_in, ws_size, (size_t)WS_END); grid = -1; return; }
        int dev = 0, cus = 0;
        if (hipGetDevice(&dev) != hipSuccess || hipDeviceGetAttribute(&cus, hipDeviceAttributeMultiprocessorCount, dev) != hipSuccess) { grid = -1; return; }
        if (hipFuncSetAttribute((const void*)fwd_kernel, hipFuncAttributeMaxDynamicSharedMemorySize, LDS_BYTES) != hipSuccess) { fprintf(stderr, "kernel_launch: hipFuncSetAttribute failed\n"); grid = -1; return; }
        int per_cu = 0;
        if (hipOccupancyMaxActiveBlocksPerMultiprocessor(&per_cu, (const void*)fwd_kernel, NWAVES * 64, LDS_BYTES) != hipSuccess || per_cu < 1) fprintf(stderr, "kernel_launch: occupancy query says %d\n", per_cu);
        (void)hipGetLastError();
        grid = cus;
    }
    if (grid < 0) return;
    (void)hipMemsetAsync((char*)d_ws + WS_CTL, 0, CTL_ZERO_BYTES, stream);
    Args a{};
    for (int i = 0; i < 19; ++i) a.in[i] = (const float*)d_in[i];
    a.out = (float*)d_out; a.ws = (unsigned char*)d_ws;
    hipLaunchKernelGGL(fwd_kernel, dim3(grid), dim3(NWAVES * 64), LDS_BYTES, stream, a);
}
```

```cpp
#include <hip/hip_runtime.h>
#include <cstdio>
#include <cstdint>

constexpr int D = 2048, FF = 5632, QKVD = 3072, DKV = 512, HD = 128;
constexpr int TC = 8192, TL = 32768, T = TC + TL;
constexpr int CSEQ = 256, LSEQ = 4096, PAST = 256, KVLEN = PAST + LSEQ;
constexpr int NB = 9;
constexpr int MODW = 9 * D;
constexpr float ALPHA = 1.4142135623730951f;
constexpr float LN_EPS = 1e-5f, QK_EPS = 1e-6f;

constexpr size_t MiB = 1u << 20;
constexpr size_t WS_CTL = 0, CTL_ZERO_BYTES = 1 * MiB;
constexpr size_t WS_MOD = 1 * MiB;
constexpr size_t WS_ROPE = 3 * MiB - 65536;
constexpr size_t WS_W13 = 3 * MiB;
constexpr size_t WS_W2 = WS_W13 + 176 * MiB;
constexpr size_t WS_WQKV = WS_W2 + 88 * MiB;
constexpr size_t WS_WO = WS_WQKV + 12 * MiB;
constexpr size_t WS_WPOOL = WS_WO + 8 * MiB;
constexpr size_t WS_H = WS_WPOOL + 2 * MiB;
constexpr size_t WS_Q = WS_H + 160 * MiB;
constexpr size_t WS_G = WS_Q + 160 * MiB;
constexpr size_t WS_QKV = WS_G;
constexpr size_t WS_KALL = WS_G + 240 * MiB;
constexpr size_t WS_VALL = WS_KALL + 34 * MiB;
constexpr size_t WS_KCTX = WS_VALL + 34 * MiB;
constexpr size_t WS_VCTX = WS_KCTX + 8 * MiB;
constexpr size_t WS_DP = WS_G;
constexpr size_t WS_END = WS_G + 440 * MiB;
static_assert(WS_VCTX + 8 * MiB <= WS_END, "ws map");
constexpr int CW_BAR = 4096;

constexpr int RING_BYTES = 131072;
constexpr int MISC_OFF = RING_BYTES + 320;
constexpr int LDS_BYTES = 147456;
constexpr int NWAVES = 8;

#define GAS __attribute__((address_space(1)))
#define LAS __attribute__((address_space(3)))
typedef unsigned short bf16;
typedef unsigned v4u __attribute__((ext_vector_type(4)));
typedef unsigned v2u __attribute__((ext_vector_type(2)));
typedef float f32x4 __attribute__((ext_vector_type(4)));
typedef float f32x2 __attribute__((ext_vector_type(2)));
typedef short bf16x8 __attribute__((ext_vector_type(8)));

__device__ __forceinline__ unsigned cvt_pk_bf16(float lo, float hi) { unsigned r; asm volatile("v_cvt_pk_bf16_f32 %0, %1, %2" : "=v"(r) : "v"(lo), "v"(hi)); return r; }
constexpr float SC_H = 16.f, SC_W13 = 64.f, SC_G = 16.f, SC_W2 = 256.f;
__device__ __forceinline__ unsigned pk4_fp8(float a, float b, float c, float d) {
    a = __builtin_amdgcn_fmed3f(a, -448.f, 448.f); b = __builtin_amdgcn_fmed3f(b, -448.f, 448.f); c = __builtin_amdgcn_fmed3f(c, -448.f, 448.f); d = __builtin_amdgcn_fmed3f(d, -448.f, 448.f);
    int w = __builtin_amdgcn_cvt_pk_fp8_f32(a, b, 0, false); w = __builtin_amdgcn_cvt_pk_fp8_f32(c, d, w, true); return (unsigned)w; }
__device__ __forceinline__ float bf_lo(unsigned w) { return __uint_as_float(w << 16); }
__device__ __forceinline__ float bf_hi(unsigned w) { return __uint_as_float(w & 0xffff0000u); }
template <int XOR> __device__ __forceinline__ float swz_xor(float v) { return __int_as_float(__builtin_amdgcn_ds_swizzle(__float_as_int(v), (XOR << 10) | 0x1f)); }
__device__ __forceinline__ float wave_sum(float v) {
    v += swz_xor<1>(v); v += swz_xor<2>(v); v += swz_xor<4>(v); v += swz_xor<8>(v); v += swz_xor<16>(v);
    const auto rr = __builtin_amdgcn_permlane32_swap(__float_as_uint(v), __float_as_uint(v), false, false);
    return __uint_as_float(rr[0]) + __uint_as_float(rr[1]);
}
__device__ __forceinline__ float silu_f(float x) { return x * __builtin_amdgcn_rcpf(1.0f + __builtin_amdgcn_exp2f(-1.4426950408889634f * x)); }
__device__ __forceinline__ int opaque_lane() { int l; asm volatile("v_mbcnt_lo_u32_b32 %0, -1, 0\n\tv_mbcnt_hi_u32_b32 %0, -1, %0" : "=v"(l)); return l; }
__device__ __forceinline__ int opaque_tid(int wv) { return (wv << 6) | opaque_lane(); }
__device__ __forceinline__ int batch_of_row(int m) { return m < TC ? 0 : 1 + ((m - TC) >> 12); }

namespace pg8 {
#define PG8_LAS __attribute__((address_space(3)))
typedef unsigned short bf16_t;
typedef int i32x4 __attribute__((ext_vector_type(4)));
typedef int i32x8 __attribute__((ext_vector_type(8)));
constexpr int BM = 256, BK = 64, HALF = 128, HTB = HALF * BK * 2, STAGE_BYTES = 8 * HTB, NXCD = 8, WGM = 8;
__host__ __device__ __forceinline__ int lds_byte(int r, int c) { const int st = (r >> 4) * 2 + (c >> 5), rr = r & 15, cc = c & 31, ob = rr * 64 + cc * 2; return st * 1024 + (ob ^ (((ob >> 9) & 1) << 5)); }
__host__ __device__ __forceinline__ void stage_rc(int b, int& R, int& C) { const int st = b / 1024, sb = b % 1024, swz = sb ^ (((sb >> 9) & 1) << 5); R = (st >> 1) * 16 + swz / 64; C = (st & 1) * 32 + (swz % 64) / 2; }
__host__ __device__ __forceinline__ int perm32(int rho) { const int n = rho >> 4, i = rho & 15; return 8 * (i >> 2) + 4 * n + (i & 3); }

struct Unit { int pm, pn; };
struct Gemm { const void* A; const void* Bt; int M, N, Kb, ldab, grouped; };

struct StaticOrder {
    int nM, nN, nwg, G, c;
    __device__ void init(int M, int N, int G_, int c_) { nM = M / BM; nN = N / BM; nwg = nM * nN; G = G_; c = c_; }
    __device__ bool next(int i, Unit& u) const {
        const long L = (long)i * G + c; if (L >= nwg) return false;
        int wgid = (int)L; { const int q = nwg / NXCD, r = nwg % NXCD, xcd = wgid % NXCD, off = wgid / NXCD; wgid = (xcd < r ? xcd * (q + 1) : r * (q + 1) + (xcd - r) * q) + off; }
        const int nig = WGM * nN, gid = wgid / nig, fm = gid * WGM, gsz = (nM - fm) < WGM ? (nM - fm) : WGM;
        u.pm = fm + ((wgid % nig) % gsz); u.pn = (wgid % nig) / gsz; return true;
    }
};

struct EpiBf16 {
    static constexpr bool PERM = true;
    bf16_t* O; int ldc;
    __device__ __forceinline__ void operator()(const f32x4 (&acc)[2][2][4][2], const Unit& u, int wr, int wc, int fr, int fq) const {
        const int row0 = u.pm * BM + wr * 64 + fr, col0 = u.pn * BM + wc * 32 + 8 * fq;
#pragma unroll
        for (int ai = 0; ai < 2; ++ai)
#pragma unroll
            for (int m = 0; m < 4; ++m) { bf16_t* rowp = O + (size_t)(row0 + ai * HALF + m * 16) * ldc + col0;
#pragma unroll
                for (int bj = 0; bj < 2; ++bj) { const f32x4 v0 = acc[ai][bj][m][0], v1 = acc[ai][bj][m][1];
                    v4u w; w.x = cvt_pk_bf16(v0[0], v0[1]); w.y = cvt_pk_bf16(v0[2], v0[3]); w.z = cvt_pk_bf16(v1[0], v1[1]); w.w = cvt_pk_bf16(v1[2], v1[3]);
                    *(v4u*)(rowp + bj * HALF) = w; } }
    }
};
struct EpiSwiGLU {
    static constexpr bool PERM = true;
    unsigned char* O; int ldc;
    __device__ __forceinline__ void operator()(const f32x4 (&acc)[2][2][4][2], const Unit& u, int wr, int wc, int fr, int fq) const {
        constexpr float ascale = 1.0f / (SC_H * SC_W13);
        const int row0 = u.pm * BM + wr * 64 + fr, col0 = u.pn * HALF + wc * 32 + 8 * fq;
#pragma unroll
        for (int ai = 0; ai < 2; ++ai)
#pragma unroll
            for (int m = 0; m < 4; ++m) { unsigned char* rowp = O + (size_t)(row0 + ai * HALF + m * 16) * ldc + col0;
                const f32x4 a0 = acc[ai][0][m][0], a1 = acc[ai][0][m][1], b0 = acc[ai][1][m][0], b1 = acc[ai][1][m][1];
                float g[8];
#pragma unroll
                for (int j = 0; j < 4; ++j) { g[j] = silu_f(a0[j] * ascale) * (b0[j] * (ascale * SC_G)); g[4 + j] = silu_f(a1[j] * ascale) * (b1[j] * (ascale * SC_G)); }
                v2u w; w.x = pk4_fp8(g[0], g[1], g[2], g[3]); w.y = pk4_fp8(g[4], g[5], g[6], g[7]);
                *(v2u*)rowp = w; }
    }
};
struct EpiResid {
    static constexpr bool PERM = false;
    float* X; int ldc; const float* gate0; int gstride; float wgt; const float* pscale;
    __device__ __forceinline__ void operator()(const f32x4 (&acc)[2][2][4][2], const Unit& u, int wr, int wc, int fr, int fq) const {
        const int row0 = u.pm * BM + wr * 64 + fr, col0 = u.pn * BM + wc * 32 + 4 * fq;
        const int bi = batch_of_row(u.pm * BM);
        const float* gv = gate0 + (size_t)bi * gstride;
        f32x4 cf[2][2];
#pragma unroll
        for (int bj = 0; bj < 2; ++bj)
#pragma unroll
            for (int n = 0; n < 2; ++n) { f32x4 g = *(const f32x4*)(gv + col0 + bj * HALF + n * 16) * wgt;
                if (pscale) g = g * *(const f32x4*)(pscale + col0 + bj * HALF + n * 16);
                cf[bj][n] = g; }
#pragma unroll
        for (int ai = 0; ai < 2; ++ai)
#pragma unroll
            for (int m = 0; m < 4; ++m) { float* rowp = X + (size_t)(row0 + ai * HALF + m * 16) * ldc + col0;
#pragma unroll
                for (int bj = 0; bj < 2; ++bj)
#pragma unroll
                    for (int n = 0; n < 2; ++n) { f32x4* p = (f32x4*)(rowp + bj * HALF + n * 16); *p = *p * ALPHA + cf[bj][n] * acc[ai][bj][m][n]; } }
    }
};

template <bool FP8> struct OpRegs;
template <> struct OpRegs<false> { struct TA { bf16x8 lo, hi; }; };
template <> struct OpRegs<true> { typedef i32x8 TA; };
template <class Epi, bool FP8>
__device__ __forceinline__ void gemm_phase(PG8_LAS unsigned char* lds, const Gemm g, const StaticOrder& S, const Epi& E, const int wid_) {
    int wid = wid_; asm volatile("" : "+s"(wid));
    const int tid = opaque_tid(wid), lane = tid & 63, wr = wid >> 2, wc = wid & 3, fr = lane & 15, fq = lane >> 4;
    const int Kb = g.Kb, nt = Kb / 128, lda = g.ldab;
    unsigned voffA, voffB;
    { int R, C; stage_rc(tid * 16, R, C); const int Rb = Epi::PERM ? ((R & ~31) + perm32(R & 31)) : R;
      voffA = (unsigned)(R * lda + 2 * C); voffB = (unsigned)(Rb * Kb + 2 * C); }
    const unsigned p2voffA = 64u * (unsigned)lda, p2voffB = 64u * (unsigned)Kb;
    const unsigned kstep = 128u;
    const unsigned hstepA = (unsigned)HALF * lda, hstepB = (unsigned)HALF * Kb;
    const unsigned tstepA = 2 * hstepA, tstepB = 2 * hstepB;
    const unsigned ldsw = (unsigned)wid * 1024u;
    const int aoff = lds_byte(wr * 64 + fr, fq * 8), boff = lds_byte(wc * 32 + fr, fq * 8);
    const __amdgpu_buffer_rsrc_t rsA = __builtin_amdgcn_make_buffer_rsrc((void*)g.A, (short)0, 0x7fffffff, 0x00020000);
    const __amdgpu_buffer_rsrc_t rsB = __builtin_amdgcn_make_buffer_rsrc((void*)g.Bt, (short)0, 0x7fffffff, 0x00020000);
#define PG8_SA(b, h) (((b) * 2 + (h)) * HTB)
#define PG8_SB(b, h) ((4 + (b) * 2 + (h)) * HTB)
#define PG8_STAGE(bufoff, rs, soff, voff) do { _Pragma("unroll") for (int _i = 0; _i < 2; ++_i) \
        __builtin_amdgcn_raw_ptr_buffer_load_lds(rs, (PG8_LAS unsigned*)(lds + (bufoff) + ldsw + _i * 8192), 16, (int)(voff), (int)((soff) + _i * p2##voff), 0, 0); } while (0)
#define PG8_LDA(dst, b, h) do { _Pragma("unroll") for (int m = 0; m < 4; ++m) { \
        if constexpr (FP8) { dst[m].lo = *(const PG8_LAS i32x4*)(lds + PG8_SA(b, h) + aoff + m * 2048); dst[m].hi = *(const PG8_LAS i32x4*)(lds + PG8_SA(b, h) + aoff + m * 2048 + 1024); } \
        else { dst[m].lo = *(const PG8_LAS bf16x8*)(lds + PG8_SA(b, h) + aoff + m * 2048); dst[m].hi = *(const PG8_LAS bf16x8*)(lds + PG8_SA(b, h) + aoff + m * 2048 + 1024); } } } while (0)
#define PG8_LDB(dst, b, h) do { _Pragma("unroll") for (int n = 0; n < 2; ++n) { \
        if constexpr (FP8) { dst[n].lo = *(const PG8_LAS i32x4*)(lds + PG8_SB(b, h) + boff + n * 2048); dst[n].hi = *(const PG8_LAS i32x4*)(lds + PG8_SB(b, h) + boff + n * 2048 + 1024); } \
        else { dst[n].lo = *(const PG8_LAS bf16x8*)(lds + PG8_SB(b, h) + boff + n * 2048); dst[n].hi = *(const PG8_LAS bf16x8*)(lds + PG8_SB(b, h) + boff + n * 2048 + 1024); } } } while (0)
#define PG8_MMA(ai, bj, At, Bt) do { __builtin_amdgcn_s_setprio(1); _Pragma("unroll") for (int m = 0; m < 4; ++m) _Pragma("unroll") for (int n = 0; n < 2; ++n) { \
        if constexpr (FP8) acc[ai][bj][m][n] = __builtin_amdgcn_mfma_scale_f32_16x16x128_f8f6f4(Bt[n], At[m], acc[ai][bj][m][n], 0, 0, 0, 0, 0, 0); \
        else { acc[ai][bj][m][n] = __builtin_amdgcn_mfma_f32_16x16x32_bf16(Bt[n].lo, At[m].lo, acc[ai][bj][m][n], 0, 0, 0); acc[ai][bj][m][n] = __builtin_amdgcn_mfma_f32_16x16x32_bf16(Bt[n].hi, At[m].hi, acc[ai][bj][m][n], 0, 0, 0); } } \
        __builtin_amdgcn_s_setprio(0); } while (0)
#define PG8_WAIT_V(n) asm volatile("s_waitcnt vmcnt(" #n ")" ::: "memory")
#define PG8_WAIT_L(n) asm volatile("s_waitcnt lgkmcnt(" #n ")" ::: "memory")
#define PG8_BAR __builtin_amdgcn_s_barrier()
#define PG8_SCHED __builtin_amdgcn_sched_barrier(0)
    Unit cur, nxt; int ui = 0;
    if (!S.next(0, cur)) return;
    f32x4 acc[2][2][4][2];
#pragma unroll
    for (int a = 0; a < 2; ++a)
#pragma unroll
        for (int b = 0; b < 2; ++b)
#pragma unroll
            for (int m = 0; m < 4; ++m)
#pragma unroll
                for (int n = 0; n < 2; ++n) acc[a][b][m][n] = (f32x4){0.f, 0.f, 0.f, 0.f};
    typename OpRegs<FP8>::TA At[4]; typename OpRegs<FP8>::TA B0[2], B1[2];
    const unsigned gk = g.grouped ? (unsigned)Kb : 0u;
    unsigned cA = (unsigned)cur.pm * tstepA + (unsigned)(cur.pn >> 1) * gk, cB = (unsigned)cur.pn * tstepB;
    PG8_STAGE(PG8_SB(0, 0), rsB, cB, voffB); PG8_STAGE(PG8_SB(0, 1), rsB, cB + hstepB, voffB); PG8_STAGE(PG8_SA(0, 0), rsA, cA, voffA); PG8_STAGE(PG8_SA(0, 1), rsA, cA + hstepA, voffA);
    if (wr == 1) PG8_BAR;
    PG8_WAIT_V(2); PG8_BAR;
    PG8_STAGE(PG8_SB(1, 0), rsB, cB + kstep, voffB); PG8_STAGE(PG8_SA(1, 0), rsA, cA + kstep, voffA); PG8_STAGE(PG8_SB(1, 1), rsB, cB + hstepB + kstep, voffB);
    PG8_WAIT_V(6); PG8_BAR;
    for (;;) {
        const bool has_next = S.next(ui + 1, nxt);
        const unsigned nA = has_next ? (unsigned)nxt.pm * tstepA + (unsigned)(nxt.pn >> 1) * gk : cA, nB = has_next ? (unsigned)nxt.pn * tstepB : cB;
        for (int t = 0; t < nt; t += 2) {
            const bool last = (t == nt - 2);
            const unsigned a1 = cA + (unsigned)(t + 1) * kstep;
            const unsigned a2 = last ? nA : cA + (unsigned)(t + 2) * kstep, b2 = last ? nB : cB + (unsigned)(t + 2) * kstep;
            const unsigned a3 = a2 + kstep, b3 = b2 + kstep;
            PG8_LDB(B0, 0, 0); PG8_LDB(B1, 0, 1); PG8_SCHED; PG8_LDA(At, 0, 0); PG8_STAGE(PG8_SA(1, 1), rsA, a1 + hstepA, voffA);
            PG8_WAIT_V(8); PG8_WAIT_L(0); PG8_BAR; PG8_MMA(0, 0, At, B0); PG8_MMA(0, 1, At, B1); PG8_BAR; PG8_SCHED;
            PG8_LDA(At, 0, 1); PG8_STAGE(PG8_SB(0, 0), rsB, b2, voffB); PG8_STAGE(PG8_SB(0, 1), rsB, b2 + hstepB, voffB); PG8_STAGE(PG8_SA(0, 0), rsA, a2, voffA);
            PG8_WAIT_V(8); PG8_WAIT_L(0); PG8_BAR; PG8_MMA(1, 0, At, B0); PG8_MMA(1, 1, At, B1); PG8_BAR; PG8_SCHED;
            PG8_LDB(B0, 1, 0); PG8_LDB(B1, 1, 1); PG8_SCHED; PG8_LDA(At, 1, 0); PG8_STAGE(PG8_SA(0, 1), rsA, a2 + hstepA, voffA);
            PG8_WAIT_V(8); PG8_WAIT_L(0); PG8_BAR; PG8_MMA(0, 0, At, B0); PG8_MMA(0, 1, At, B1); PG8_BAR; PG8_SCHED;
            PG8_LDA(At, 1, 1); PG8_STAGE(PG8_SB(1, 0), rsB, b3, voffB); PG8_STAGE(PG8_SB(1, 1), rsB, b3 + hstepB, voffB); PG8_STAGE(PG8_SA(1, 0), rsA, a3, voffA);
            PG8_WAIT_V(8); PG8_WAIT_L(0); PG8_BAR; PG8_MMA(1, 0, At, B0); PG8_MMA(1, 1, At, B1); PG8_BAR; PG8_SCHED;
        }
        if (wr == 0) PG8_BAR;
        { const int el = opaque_lane(); E(acc, cur, wr, wc, el & 15, el >> 4); }
        if (!has_next) break;
#pragma unroll
        for (int a = 0; a < 2; ++a)
#pragma unroll
            for (int b = 0; b < 2; ++b)
#pragma unroll
                for (int m = 0; m < 4; ++m)
#pragma unroll
                    for (int n = 0; n < 2; ++n) acc[a][b][m][n] = (f32x4){0.f, 0.f, 0.f, 0.f};
        cur = nxt; cA = nA; cB = nB; ++ui;
        if (wr == 1) PG8_BAR;
    }
    PG8_WAIT_V(0);
    PG8_BAR;
#undef PG8_SA
#undef PG8_SB
#undef PG8_STAGE
#undef PG8_LDA
#undef PG8_LDB
#undef PG8_MMA
#undef PG8_WAIT_V
#undef PG8_WAIT_L
#undef PG8_BAR
#undef PG8_SCHED
}
}

namespace att {
constexpr int NW = 8, QBLK = 32, KVBLK = 64;
constexpr float SCALE = 0.088388347648318440f;
constexpr float THR = 8.f;
constexpr int LDQ = D, LDK = DKV, LDO = D;
constexpr size_t SHM_V = KVBLK * HD * 2, SHM_K = KVBLK * HD * 2, SHM_ATTN = 2 * SHM_V + 2 * SHM_K + NW * 64 * 4;
using s16x4 = __attribute__((ext_vector_type(4))) short;
using f32x16 = __attribute__((ext_vector_type(16))) float;
using u32x4 = __attribute__((ext_vector_type(4))) unsigned;
#define KSWZ(row, colB) ((row) * 256 + ((colB) ^ (((row) & 7) << 4)))
#define SBAR() __builtin_amdgcn_sched_barrier(0)
__device__ __forceinline__ int crow(int r, int hi) { return (r & 3) + 8 * (r >> 2) + 4 * hi; }
__device__ __forceinline__ unsigned cvtpk(float lo, float hi) { unsigned r; asm volatile("v_cvt_pk_bf16_f32 %0, %1, %2" : "=v"(r) : "v"(lo), "v"(hi)); return r; }

__device__ __forceinline__ void partialSM(f32x16& p0, f32x16& p1, float& m_reg, float& mn, float& alpha) {
  constexpr float C = SCALE * 1.4426950408889634f;
  float pmax = p0[0]; for (int r = 1; r < 16; ++r) pmax = fmaxf(pmax, p0[r]); for (int r = 0; r < 16; ++r) pmax = fmaxf(pmax, p1[r]);
  { auto rr = __builtin_amdgcn_permlane32_swap(__float_as_uint(pmax), __float_as_uint(pmax), false, false);
    pmax = fmaxf(__uint_as_float(rr[0]), __uint_as_float(rr[1])); }
  if (__builtin_expect(__all(pmax - m_reg <= THR / SCALE), 1)) { mn = m_reg; alpha = 1.f; }
  else { mn = fmaxf(m_reg, pmax); alpha = __builtin_amdgcn_exp2f((m_reg - mn) * C); m_reg = mn; }
  float mnC = -mn * C;
  for (int r = 0; r < 16; ++r) p0[r] = fmaf(p0[r], C, mnC); for (int r = 0; r < 16; ++r) p1[r] = fmaf(p1[r], C, mnC);
  for (int r = 0; r < 16; ++r) p0[r] = __builtin_amdgcn_exp2f(p0[r]);
}
__device__ __forceinline__ void finishSM(f32x16& p0, f32x16& p1, float alpha, float& l_reg, bf16x8& pa0, bf16x8& pa1, bf16x8& pa2, bf16x8& pa3) {
  for (int r = 0; r < 16; ++r) p1[r] = __builtin_amdgcn_exp2f(p1[r]);
  float ps = 0; for (int r = 0; r < 16; ++r) ps += p0[r]; for (int r = 0; r < 16; ++r) ps += p1[r];
  { auto rr = __builtin_amdgcn_permlane32_swap(__float_as_uint(ps), __float_as_uint(ps), false, false);
    ps = __uint_as_float(rr[0]) + __uint_as_float(rr[1]); }
  l_reg = l_reg * alpha + ps;
#define PK4(P, BASE, OUT) do { unsigned a0 = cvtpk(P[BASE + 0], P[BASE + 1]), a1 = cvtpk(P[BASE + 2], P[BASE + 3]);   \
    unsigned b0 = cvtpk(P[BASE + 4], P[BASE + 5]), b1 = cvtpk(P[BASE + 6], P[BASE + 7]);                              \
    auto r0 = __builtin_amdgcn_permlane32_swap(a0, b0, false, false); auto r1 = __builtin_amdgcn_permlane32_swap(a1, b1, false, false); \
    u32x4 w = {r0[0], r1[0], r0[1], r1[1]}; OUT = *reinterpret_cast<bf16x8*>(&w); } while (0)
  PK4(p0, 0, pa0); PK4(p0, 8, pa1); PK4(p1, 0, pa2); PK4(p1, 8, pa3);
#undef PK4
}
__device__ __forceinline__ void qkt(f32x16& p0, f32x16& p1, const bf16* Ks, const bf16x8* qr, int r32, int hi) {
  p0 = f32x16{}; p1 = f32x16{};
  for (int d0 = 0; d0 < 8; ++d0) { int cb = (d0 * 16 + hi * 8) * 2;
    bf16x8 b0 = *reinterpret_cast<const bf16x8*>((const char*)Ks + KSWZ(r32, cb));
    bf16x8 b1 = *reinterpret_cast<const bf16x8*>((const char*)Ks + KSWZ(32 + r32, cb));
    p0 = __builtin_amdgcn_mfma_f32_32x32x16_bf16(b0, qr[d0], p0, 0, 0, 0);
    p1 = __builtin_amdgcn_mfma_f32_32x32x16_bf16(b1, qr[d0], p1, 0, 0, 0); }
}
__device__ __forceinline__ int v_st(int k, int c) { const int kk = (k & ~0xC) | ((k & 4) << 1) | ((k & 8) >> 1); return ((kk >> 3) * 4 + (c >> 5)) * 512 + ((kk & 7) * 32 + (c & 31)) * 2; }
__device__ __forceinline__ int v_rd_base(int lane) { return ((lane & 3) << 3) | (((lane >> 2) & 3) << 6) | (((lane >> 4) & 1) << 5) | (((lane >> 5) & 1) << 8); }
constexpr int v_rd_off(int d0, int ks, int half) { return d0 * 512 + ks * 4096 + half * 2048; }
template <int OFF> __device__ __forceinline__ s16x4 tr_read(int vb) {
  s16x4 r; asm volatile("ds_read_b64_tr_b16 %0, %1 offset:%2" : "=&v"(r) : "v"(vb), "i"(OFF) : "memory"); return r;
}
template <int D0> __device__ __forceinline__ void pv_one(f32x16& od, int vb, bf16x8 pa0, bf16x8 pa1, bf16x8 pa2, bf16x8 pa3) {
  const s16x4 l0 = tr_read<v_rd_off(D0, 0, 0)>(vb), h0 = tr_read<v_rd_off(D0, 0, 1)>(vb), l1 = tr_read<v_rd_off(D0, 1, 0)>(vb), h1 = tr_read<v_rd_off(D0, 1, 1)>(vb);
  const s16x4 l2 = tr_read<v_rd_off(D0, 2, 0)>(vb), h2 = tr_read<v_rd_off(D0, 2, 1)>(vb), l3 = tr_read<v_rd_off(D0, 3, 0)>(vb), h3 = tr_read<v_rd_off(D0, 3, 1)>(vb);
  asm volatile("s_waitcnt lgkmcnt(0)" ::: "memory"); SBAR();
#define PK(L, H) (bf16x8){L[0], L[1], L[2], L[3], H[0], H[1], H[2], H[3]}
  od = __builtin_amdgcn_mfma_f32_32x32x16_bf16(pa0, PK(l0, h0), od, 0, 0, 0);
  od = __builtin_amdgcn_mfma_f32_32x32x16_bf16(pa1, PK(l1, h1), od, 0, 0, 0);
  od = __builtin_amdgcn_mfma_f32_32x32x16_bf16(pa2, PK(l2, h2), od, 0, 0, 0);
  od = __builtin_amdgcn_mfma_f32_32x32x16_bf16(pa3, PK(l3, h3), od, 0, 0, 0);
#undef PK
}
__device__ __forceinline__ void pv_d0(f32x16* o, int vb, bf16x8 pa0, bf16x8 pa1, bf16x8 pa2, bf16x8 pa3) {
  pv_one<0>(o[0], vb, pa0, pa1, pa2, pa3); pv_one<1>(o[1], vb, pa0, pa1, pa2, pa3); pv_one<2>(o[2], vb, pa0, pa1, pa2, pa3); pv_one<3>(o[3], vb, pa0, pa1, pa2, pa3);
}
__device__ __forceinline__ void attn_dense_body(const bf16* __restrict__ Qb, const bf16* __restrict__ Kh, const bf16* __restrict__ Vh, bf16* Ob, int seq, char* lds, const int wv_) {
  int wv = wv_; asm volatile("" : "+s"(wv));
  const int tid = opaque_tid(wv), wid = wv, lane = tid & 63, r32 = lane & 31, hi = lane >> 5;
  bf16* V_lds = (bf16*)lds; bf16* K_lds = (bf16*)(lds + 2 * SHM_V);
  float* ws = (float*)(lds + 2 * SHM_V + 2 * SHM_K) + wid * 64; float* li_l = ws; float* al_l = ws + 32;
  float m_reg = -1e30f, l_reg = 0; f32x16 o[4] = {}; bf16x8 qr[8];
  const bf16* Qw = Qb + (long)(wid * QBLK + r32) * LDQ + hi * 8;
#pragma unroll
  for (int d0 = 0; d0 < 8; ++d0) qr[d0] = *reinterpret_cast<const bf16x8*>(Qw + d0 * 16);
  const int sr = tid >> 4, sc = (tid & 15) * 8, vst0 = v_st(sr, sc), vst1 = v_st(32 + sr, sc);
  const int vb0 = (int)(uintptr_t)V_lds + v_rd_base(lane);
  struct { bf16x8 vs0, vs1, ks0, ks1; } sr_[2];
#define SLOAD(i, k0) do { sr_[i].vs0 = *reinterpret_cast<const bf16x8*>(&Vh[(long)((k0) + sr) * LDK + sc]); sr_[i].vs1 = *reinterpret_cast<const bf16x8*>(&Vh[(long)((k0) + 32 + sr) * LDK + sc]); \
    sr_[i].ks0 = *reinterpret_cast<const bf16x8*>(&Kh[(long)((k0) + sr) * LDK + sc]); sr_[i].ks1 = *reinterpret_cast<const bf16x8*>(&Kh[(long)((k0) + 32 + sr) * LDK + sc]); } while (0)
#define SWRITE(b, i) do { *(bf16x8*)((char*)V_lds + (b) * SHM_V + vst0) = sr_[i].vs0;          \
    *(bf16x8*)((char*)V_lds + (b) * SHM_V + vst1) = sr_[i].vs1; int kc = sc * 2;               \
    *(bf16x8*)((char*)K_lds + (b) * SHM_K + KSWZ(sr, kc)) = sr_[i].ks0;                       \
    *(bf16x8*)((char*)K_lds + (b) * SHM_K + KSWZ(32 + sr, kc)) = sr_[i].ks1; } while (0)
#define SWAIT() asm volatile("s_waitcnt vmcnt(4)" ::: "memory")
#define RESC(a) do { if (__any((a) < 1.f)) { if (hi == 0) al_l[r32] = (a); asm volatile("s_waitcnt lgkmcnt(0)" ::: "memory"); \
    for (int d = 0; d < 4; ++d) for (int r = 0; r < 16; ++r) o[d][r] *= al_l[crow(r, hi)]; } } while (0)
  f32x16 pA0, pA1, pB0, pB1; float mnA, mnB, alA, alB; bf16x8 pa0, pa1, pa2, pa3; const int NT = seq / KVBLK;
  constexpr int SE = 0, SO = 1;
  SLOAD(SE, 0); asm volatile("s_waitcnt vmcnt(0)" ::: "memory"); SWRITE(0, SE); __syncthreads();
  qkt(pA0, pA1, K_lds, qr, r32, hi); partialSM(pA0, pA1, m_reg, mnA, alA);
  SLOAD(SO, KVBLK); if (2 < NT) SLOAD(SE, 2 * KVBLK);
  SWAIT(); SWRITE(1, SO); __syncthreads();
  for (int j = 1; j + 1 < NT; j += 2) {
    SBAR(); qkt(pB0, pB1, (bf16*)((char*)K_lds + SHM_K), qr, r32, hi);
    finishSM(pA0, pA1, alA, l_reg, pa0, pa1, pa2, pa3); SBAR();
    SLOAD(SO, (j + 2) * KVBLK); SBAR();
    pv_d0(o, vb0, pa0, pa1, pa2, pa3); partialSM(pB0, pB1, m_reg, mnB, alB);
    __syncthreads(); SWAIT(); SWRITE(0, SE);
    RESC(alB); __syncthreads();
    SBAR(); qkt(pA0, pA1, K_lds, qr, r32, hi);
    finishSM(pB0, pB1, alB, l_reg, pa0, pa1, pa2, pa3); SBAR();
    if (j + 3 < NT) SLOAD(SE, (j + 3) * KVBLK); SBAR();
    pv_d0(o, vb0 + (int)SHM_V, pa0, pa1, pa2, pa3); partialSM(pA0, pA1, m_reg, mnA, alA);
    __syncthreads(); SWAIT(); SWRITE(1, SO);
    RESC(alA); __syncthreads();
  }
  SBAR(); qkt(pB0, pB1, (bf16*)((char*)K_lds + SHM_K), qr, r32, hi);
  finishSM(pA0, pA1, alA, l_reg, pa0, pa1, pa2, pa3); SBAR();
  pv_d0(o, vb0, pa0, pa1, pa2, pa3); partialSM(pB0, pB1, m_reg, mnB, alB);
  __syncthreads(); RESC(alB);
  finishSM(pB0, pB1, alB, l_reg, pa0, pa1, pa2, pa3); SBAR();
  pv_d0(o, vb0 + (int)SHM_V, pa0, pa1, pa2, pa3);
  if (hi == 0) li_l[r32] = l_reg; asm volatile("s_waitcnt lgkmcnt(0)" ::: "memory");
  float rli[16];
#pragma unroll
  for (int r = 0; r < 16; ++r) rli[r] = __builtin_amdgcn_rcpf(li_l[crow(r, hi)]);
  bf16* Ow = Ob + (long)(wid * QBLK) * LDO;
#pragma unroll
  for (int r = 0; r < 16; ++r) { int orow = crow(r, hi);
    for (int d0 = 0; d0 < 4; ++d0) Ow[(long)orow * LDO + d0 * 32 + r32] = (bf16)(cvtpk(o[d0][r] * rli[r], 0.f) & 0xffffu); }
#undef SLOAD
#undef SWRITE
#undef SWAIT
#undef RESC
}
}

#define XB_TMO      128
#define XB_XCNT(j)  (256  + 64 * (j))
#define XB_XSUB(j)  (1280 + 64 * (j))
#define XB_XGEN(j)  (2304 + 64 * (j))
#define XB_TOP      3328
#define XB_TOPGEN   3392
#define XCD_BAR_WORDS 3456
#define XB_SPIN_CAP (1u << 20)
__device__ __forceinline__ unsigned xb_ld(unsigned* p)              { return __hip_atomic_load(p, __ATOMIC_RELAXED, __HIP_MEMORY_SCOPE_AGENT); }
__device__ __forceinline__ unsigned xb_add(unsigned* p, unsigned v) { return __hip_atomic_fetch_add(p, v, __ATOMIC_RELAXED, __HIP_MEMORY_SCOPE_AGENT); }
__device__ __forceinline__ unsigned xb_xcc_id() { return (unsigned)__builtin_amdgcn_s_getreg((3 << 11) | 20) & 0xFu; }
#define XB_SPIN(cond, bar) do { unsigned _sp = 0; while (cond) { __builtin_amdgcn_s_sleep(1); \
    if ((++_sp & 255u) == 0u) { if (xb_ld(&(bar)[XB_TMO])) break; if (_sp > XB_SPIN_CAP) { atomicAdd(&(bar)[XB_TMO], 1u); break; } } } } while (0)
struct XcdBarrier { unsigned* bar; unsigned x; volatile LAS unsigned* st; };
__device__ __forceinline__ XcdBarrier xcd_barrier_post(unsigned* bar, volatile LAS unsigned* st) {
    XcdBarrier b; b.bar = bar; b.x = xb_xcc_id(); b.st = st;
    if (threadIdx.x == 0) (void)xb_add(&bar[XB_XCNT(b.x)], 1u);
    return b;
}
__device__ __forceinline__ void xcd_barrier_complete(unsigned* bar, unsigned x, unsigned& nloc, unsigned& nx) {
    const unsigned G = gridDim.x * gridDim.y * gridDim.z;
    unsigned sum, cnt, mine, sp = 0u;
    for (;;) {
        sum = 0u; cnt = 0u; mine = 0u;
#pragma unroll
        for (unsigned j = 0; j < 16; ++j) { const unsigned c = xb_ld(&bar[XB_XCNT(j)]); sum += c; cnt += (c > 0u) ? 1u : 0u; mine = (j == x) ? c : mine; }
        if (sum == G) break;
        __builtin_amdgcn_s_sleep(1);
        if ((++sp & 255u) == 0u) { if (xb_ld(&bar[XB_TMO])) break; if (sp > XB_SPIN_CAP) { atomicAdd(&bar[XB_TMO], 1u); break; } }
    }
    nloc = mine > 0u ? mine : 1u; nx = cnt > 0u ? cnt : 1u;
}
__device__ __forceinline__ void xcd_barrier(const XcdBarrier& b) {
    asm volatile("s_waitcnt vmcnt(0)" ::: "memory");
    __syncthreads();
    if (threadIdx.x == 0) {
        unsigned* bar = b.bar;
        __builtin_amdgcn_s_waitcnt(0);
        unsigned nloc = b.st[0], nx = b.st[1];
        if (nloc == 0u) { xcd_barrier_complete(bar, b.x, nloc, nx); b.st[0] = nloc; b.st[1] = nx; }
        const unsigned old = xb_add(&bar[XB_XSUB(b.x)], 1u);
        const unsigned gen = old / nloc;
        if (old + 1u == (gen + 1u) * nloc) {
            __builtin_amdgcn_fence(__ATOMIC_RELEASE, "agent");
            asm volatile("s_waitcnt vmcnt(0)" ::: "memory");
            const unsigned og = xb_add(&bar[XB_TOP], 1u);
            const unsigned tg = og / nx;
            if (og + 1u == (tg + 1u) * nx) xb_add(&bar[XB_TOPGEN], 1u);
            else XB_SPIN(xb_ld(&bar[XB_TOPGEN]) == tg, bar);
            __builtin_amdgcn_fence(__ATOMIC_ACQUIRE, "agent");
            xb_add(&bar[XB_XGEN(b.x)], 1u);
            asm volatile("s_waitcnt vmcnt(0)" ::: "memory");
        } else {
            XB_SPIN(xb_ld(&bar[XB_XGEN(b.x)]) == gen, bar);
            __builtin_amdgcn_fence(__ATOMIC_ACQUIRE, "agent");
            asm volatile("s_waitcnt vmcnt(0)" ::: "memory");
        }
    }
    __syncthreads();
}

struct Args { const float* in[19]; float* out; unsigned char* ws; };
struct Frame {
    unsigned char* lds; int tid, lane, wave, vcu, G;
    const float *x_prompt, *x_sample, *cache_k, *cache_v, *c, *c_ctx, *w_mod, *b_mod, *ln_g, *ln_b, *w1, *w3, *w2, *w_qkv, *q_gain, *k_gain, *w_o, *w_pool, *pool_scale;
    float* X; float* ctxk; float* ctxv;
    float* mod; float* rope; unsigned char* ws;
    unsigned char *W13, *W2, *Gb;
    bf16 *Wqkv, *Wo, *Wpool, *H, *Q, *QKV, *KALL, *VALL, *KCTX, *VCTX, *DP;
};
#define LDS_WAIT() asm volatile("s_waitcnt lgkmcnt(0)" ::: "memory")
extern __shared__ __attribute__((aligned(16))) unsigned char g_lds[];
typedef const Args __attribute__((address_space(4)))* KArgs;
__device__ __forceinline__ Frame fresh_frame(const int wv_) {
    int wv = wv_; asm volatile("" : "+s"(wv));
    KArgs ka = (KArgs)__builtin_amdgcn_kernarg_segment_ptr();
    asm volatile("" : "+s"(ka));
    Frame F;
    F.lds = g_lds; F.tid = opaque_tid(wv); F.lane = F.tid & 63; F.wave = wv;
    F.G = gridDim.x; { const int bx = blockIdx.x; F.vcu = (F.G % 8 == 0) ? (bx % 8) * (F.G / 8) + bx / 8 : bx; }
    F.x_prompt = ka->in[0]; F.x_sample = ka->in[1]; F.cache_k = ka->in[2]; F.cache_v = ka->in[3]; F.c = ka->in[4]; F.c_ctx = ka->in[5]; F.w_mod = ka->in[6]; F.b_mod = ka->in[7];
    F.ln_g = ka->in[8]; F.ln_b = ka->in[9]; F.w1 = ka->in[10]; F.w3 = ka->in[11]; F.w2 = ka->in[12]; F.w_qkv = ka->in[13]; F.q_gain = ka->in[14]; F.k_gain = ka->in[15];
    F.w_o = ka->in[16]; F.w_pool = ka->in[17]; F.pool_scale = ka->in[18];
    float* out = ka->out; unsigned char* ws = ka->ws;
    F.X = out; F.ctxk = out + (size_t)T * D; F.ctxv = F.ctxk + (size_t)TC * DKV;
    F.ws = ws; F.mod = (float*)(ws + WS_MOD); F.rope = (float*)(ws + WS_ROPE);
    F.W13 = ws + WS_W13; F.W2 = ws + WS_W2; F.Wqkv = (bf16*)(ws + WS_WQKV); F.Wo = (bf16*)(ws + WS_WO); F.Wpool = (bf16*)(ws + WS_WPOOL);
    F.H = (bf16*)(ws + WS_H); F.Q = (bf16*)(ws + WS_Q); F.Gb = ws + WS_G; F.QKV = (bf16*)(ws + WS_QKV);
    F.KALL = (bf16*)(ws + WS_KALL); F.VALL = (bf16*)(ws + WS_VALL); F.KCTX = (bf16*)(ws + WS_KCTX); F.VCTX = (bf16*)(ws + WS_VCTX); F.DP = (bf16*)(ws + WS_DP);
    return F;
}
__device__ __forceinline__ void grid_barrier();

template <bool FP8>
__device__ __forceinline__ void transpose_item(const float* W, int K, int N, void* WT, int k0, int n0, int drow0, float* scr, int lane, float scale) {
#pragma unroll 8
    for (int i = 0; i < 32; ++i) { const int kk = 2 * i + (lane >> 5); scr[kk * 33 + (lane & 31)] = W[(size_t)(k0 + kk) * N + n0 + (lane & 31)]; }
    LDS_WAIT(); asm volatile("" ::: "memory");
    const int c = lane & 7;
#pragma unroll
    for (int j = 0; j < 4; ++j) { const int n = (lane >> 3) + 8 * j; const float* s = scr + (8 * c) * 33 + n;
        if constexpr (FP8) { v2u o; o.x = pk4_fp8(s[0 * 33] * scale, s[1 * 33] * scale, s[2 * 33] * scale, s[3 * 33] * scale); o.y = pk4_fp8(s[4 * 33] * scale, s[5 * 33] * scale, s[6 * 33] * scale, s[7 * 33] * scale);
            *(v2u*)((unsigned char*)WT + (size_t)(drow0 + n) * K + k0 + 8 * c) = o; }
        else { v4u o; o.x = cvt_pk_bf16(s[0 * 33], s[1 * 33]); o.y = cvt_pk_bf16(s[2 * 33], s[3 * 33]); o.z = cvt_pk_bf16(s[4 * 33], s[5 * 33]); o.w = cvt_pk_bf16(s[6 * 33], s[7 * 33]);
            *(v4u*)((bf16*)WT + (size_t)(drow0 + n) * K + k0 + 8 * c) = o; } }
    LDS_WAIT(); asm volatile("" ::: "memory");
}

__device__ __forceinline__ void sincos_small(double a, double& s, double& c) {
    const double n = __builtin_rint(a * 0.63661977236758134308);
    const double r = (a - n * 1.5707963267948966192) - n * 6.123233995736766036e-17;
    const double r2 = r * r;
    double sp = -1.0 / 1307674368000.0; sp = sp * r2 + 1.0 / 6227020800.0; sp = sp * r2 - 1.0 / 39916800.0; sp = sp * r2 + 1.0 / 362880.0; sp = sp * r2 - 1.0 / 5040.0; sp = sp * r2 + 1.0 / 120.0; sp = sp * r2 - 1.0 / 6.0; sp = sp * r2 + 1.0; sp = sp * r;
    double cp = 1.0 / 20922789888000.0; cp = cp * r2 - 1.0 / 87178291200.0; cp = cp * r2 + 1.0 / 479001600.0; cp = cp * r2 - 1.0 / 3628800.0; cp = cp * r2 + 1.0 / 40320.0; cp = cp * r2 - 1.0 / 720.0; cp = cp * r2 + 1.0 / 24.0; cp = cp * r2 - 0.5; cp = cp * r2 + 1.0;
    const int q = ((int)n) & 3;
    s = (q == 0) ? sp : (q == 1) ? cp : (q == 2) ? -sp : -cp;
    c = (q == 0) ? cp : (q == 1) ? -sp : (q == 2) ? -cp : sp;
}

__device__ __forceinline__ void p0_prologue(const int wv) {
    Frame F = fresh_frame(wv);
    float* sc = (float*)F.lds;
    float* part = (float*)(F.lds + 73728);
    for (int i = F.tid; i < NB * D; i += 512) { const int bi = i >> 11, k = i & 2047; const float v = bi == 0 ? F.c_ctx[k] : F.c[(bi - 1) * D + k]; sc[i] = v / (1.0f + __expf(-v)); }
    __syncthreads();
    for (int u = F.vcu; u < 2 * 72; u += F.G) {
        const int l = u / 72, cb = u % 72;
        const float* W = F.w_mod + (size_t)l * D * MODW + cb * 256 + F.lane * 4;
        f32x4 acc[NB];
#pragma unroll
        for (int bi = 0; bi < NB; ++bi) acc[bi] = (f32x4){0.f, 0.f, 0.f, 0.f};
        const int kb = F.wave * 256;
#pragma unroll 8
        for (int kk = 0; kk < 256; ++kk) { const f32x4 w = *(const f32x4*)(W + (size_t)(kb + kk) * MODW);
#pragma unroll
            for (int bi = 0; bi < NB; ++bi) acc[bi] += w * sc[bi * D + kb + kk]; }
        if (F.wave >= 4) {
#pragma unroll
            for (int bi = 0; bi < NB; ++bi) *(f32x4*)(part + ((F.wave - 4) * NB + bi) * 256 + F.lane * 4) = acc[bi];
        }
        __syncthreads();
        if (F.wave < 4) {
#pragma unroll
            for (int bi = 0; bi < NB; ++bi) acc[bi] += *(const f32x4*)(part + (F.wave * NB + bi) * 256 + F.lane * 4);
        }
        __syncthreads();
        if (F.wave < 4) {
#pragma unroll
            for (int bi = 0; bi < NB; ++bi) *(f32x4*)(part + (F.wave * NB + bi) * 256 + F.lane * 4) = acc[bi];
        }
        __syncthreads();
        for (int idx = F.tid; idx < NB * 256; idx += 512) { const int bi = idx >> 8, cc = idx & 255;
            float s = F.b_mod[l * MODW + cb * 256 + cc];
#pragma unroll
            for (int w = 0; w < 4; ++w) s += part[(w * NB + bi) * 256 + cc];
            F.mod[((size_t)l * NB + bi) * MODW + cb * 256 + cc] = s; }
        __syncthreads();
    }
    __syncthreads();
    float* scr = (float*)(F.lds + F.wave * 16384);
    const int gw = F.vcu * NWAVES + F.wave, NGW = F.G * NWAVES;
    constexpr int I13 = (D / 64) * (FF / 32), I2 = (FF / 64) * (D / 32), IQ = (D / 64) * (QKVD / 32), IO = (D / 64) * (D / 32), IP = (512 / 64) * (512 / 32);
    constexpr int NITEMS = 8 * I13 + 4 * I2 + IQ + IO + 4 * IP;
    for (int it = gw; it < NITEMS; it += NGW) {
        int r = it;
        if (r < 8 * I13) { const int which = r / (4 * I13); r -= which * 4 * I13; const int mat = r / I13, q = r % I13, kbk = q / (FF / 32), nb = q % (FF / 32), n0 = nb * 32;
            transpose_item<true>((which ? F.w3 : F.w1) + (size_t)mat * D * FF, D, FF, F.W13 + (size_t)mat * 2 * FF * D, kbk * 64, n0, 256 * (n0 >> 7) + (n0 & 127) + which * 128, scr, F.lane, SC_W13); continue; }
        r -= 8 * I13;
        if (r < 4 * I2) { const int mat = r / I2, q = r % I2, kbk = q / (D / 32), nb = q % (D / 32);
            transpose_item<true>(F.w2 + (size_t)mat * FF * D, FF, D, F.W2 + (size_t)mat * D * FF, kbk * 64, nb * 32, nb * 32, scr, F.lane, SC_W2); continue; }
        r -= 4 * I2;
        if (r < IQ) { const int kbk = r / (QKVD / 32), nb = r % (QKVD / 32); transpose_item<false>(F.w_qkv, D, QKVD, F.Wqkv, kbk * 64, nb * 32, nb * 32, scr, F.lane, 1.f); continue; }
        r -= IQ;
        if (r < IO) { const int kbk = r / (D / 32), nb = r % (D / 32); transpose_item<false>(F.w_o, D, D, F.Wo, kbk * 64, nb * 32, nb * 32, scr, F.lane, 1.f); continue; }
        r -= IO;
        { const int grp = r / IP, q = r % IP, kbk = q / 16, nb = q % 16; transpose_item<false>(F.w_pool + (size_t)grp * 512 * 512, 512, 512, F.Wpool + (size_t)grp * 512 * 512, kbk * 64, nb * 32, nb * 32, scr, F.lane, 1.f); }
    }
    for (int i8 = F.vcu * 512 + F.tid; i8 < 8 * PAST * DKV / 8; i8 += F.G * 512) {
        const int e = i8 * 8, b = e / (PAST * DKV), rem = e % (PAST * DKV);
        const f32x4 k0 = *(const f32x4*)(F.cache_k + e), k1 = *(const f32x4*)(F.cache_k + e + 4), v0 = *(const f32x4*)(F.cache_v + e), v1 = *(const f32x4*)(F.cache_v + e + 4);
        v4u kw, vw; kw.x = cvt_pk_bf16(k0[0], k0[1]); kw.y = cvt_pk_bf16(k0[2], k0[3]); kw.z = cvt_pk_bf16(k1[0], k1[1]); kw.w = cvt_pk_bf16(k1[2], k1[3]);
        vw.x = cvt_pk_bf16(v0[0], v0[1]); vw.y = cvt_pk_bf16(v0[2], v0[3]); vw.z = cvt_pk_bf16(v1[0], v1[1]); vw.w = cvt_pk_bf16(v1[2], v1[3]);
        *(v4u*)(F.KALL + (size_t)b * KVLEN * DKV + rem) = kw; *(v4u*)(F.VALL + (size_t)b * KVLEN * DKV + rem) = vw;
    }
    { const int gid = F.vcu * 512 + F.tid;
      if (gid < 2048) { const int pos = gid >> 5, i = gid & 31; const double freq = exp(-(double)i * (9.210340371976182736 / 32.0)); double s, c; sincos_small((double)pos * freq, s, c);
          F.rope[gid] = (float)c; F.rope[2048 + gid] = (float)s; } }
}

template <int MODE, int HOUT>
__device__ __forceinline__ void row_phase(const int wv, int lnidx  , int modidx  ) {
    Frame F = fresh_frame(wv);
    const float* lng = F.ln_g + (size_t)lnidx * D; const float* lnb = F.ln_b + (size_t)lnidx * D; const float* modv = F.mod + modidx;
    const int gw = F.vcu * NWAVES + F.wave, NGW = F.G * NWAVES;
    const int per = (T + NGW - 1) / NGW;
    f32x4 gv[8], bv[8], sh[8], sc1[8];
    if (MODE == 1) {
#pragma unroll
        for (int j = 0; j < 8; ++j) { gv[j] = *(const f32x4*)(lng + 256 * j + 4 * F.lane); bv[j] = *(const f32x4*)(lnb + 256 * j + 4 * F.lane); }
    }
    int cur_bi = -1;
    for (int m = gw * per; m < (gw + 1) * per && m < T; ++m) {
        const int bi = batch_of_row(m);
        if (HOUT != 0 && bi != cur_bi) { cur_bi = bi; const float* mv = modv + (size_t)bi * MODW;
#pragma unroll
            for (int j = 0; j < 8; ++j) { sh[j] = *(const f32x4*)(mv + 256 * j + 4 * F.lane); sc1[j] = *(const f32x4*)(mv + D + 256 * j + 4 * F.lane) + 1.0f; } }
        const float* src = MODE == 0 ? (m < TC ? F.x_prompt + (size_t)m * D : F.x_sample + (size_t)(m - TC) * D) : F.X + (size_t)m * D;
        f32x4 v[8];
#pragma unroll
        for (int j = 0; j < 8; ++j) v[j] = *(const f32x4*)(src + 256 * j + 4 * F.lane);
        if (MODE == 1) {
            float s = 0.f;
#pragma unroll
            for (int j = 0; j < 8; ++j) s += (v[j].x + v[j].y) + (v[j].z + v[j].w);
            const float mean = wave_sum(s) * (1.f / D); float s2 = 0.f;
#pragma unroll
            for (int j = 0; j < 8; ++j) { v[j] = v[j] - mean; s2 += (v[j].x * v[j].x + v[j].y * v[j].y) + (v[j].z * v[j].z + v[j].w * v[j].w); }
            const float rstd = 1.f / sqrtf(wave_sum(s2) * (1.f / D) + LN_EPS);
#pragma unroll
            for (int j = 0; j < 8; ++j) v[j] = v[j] * rstd * gv[j] + bv[j];
        }
        float* xo = F.X + (size_t)m * D;
#pragma unroll
        for (int j = 0; j < 8; ++j) *(f32x4*)(xo + 256 * j + 4 * F.lane) = v[j];
        if (HOUT == 1) {
            bf16* ho = F.H + (size_t)m * D;
#pragma unroll
            for (int j = 0; j < 8; ++j) { const f32x4 h = v[j] * sc1[j] + sh[j]; v2u w; w.x = cvt_pk_bf16(h.x, h.y); w.y = cvt_pk_bf16(h.z, h.w); *(v2u*)(ho + 256 * j + 4 * F.lane) = w; }
        }
        if (HOUT == 2) {
            unsigned char* ho = (unsigned char*)F.H + (size_t)m * D;
#pragma unroll
            for (int j = 0; j < 8; ++j) { const f32x4 h = (v[j] * sc1[j] + sh[j]) * SC_H; *(unsigned*)(ho + 256 * j + 4 * F.lane) = pk4_fp8(h.x, h.y, h.z, h.w); }
        }
    }
}

__device__ __forceinline__ void qkv_post(const int wv) {
    Frame F = fresh_frame(wv);
    const int gw = F.vcu * NWAVES + F.wave, NGW = F.G * NWAVES;
    const int c16 = F.lane & 15, hq = F.lane >> 4;
    f32x4 qg0 = *(const f32x4*)(F.q_gain + 8 * c16), qg1 = *(const f32x4*)(F.q_gain + 8 * c16 + 4), kg0 = *(const f32x4*)(F.k_gain + 8 * c16), kg1 = *(const f32x4*)(F.k_gain + 8 * c16 + 4);
    const float qg[8] = {qg0.x, qg0.y, qg0.z, qg0.w, qg1.x, qg1.y, qg1.z, qg1.w}, kg[8] = {kg0.x, kg0.y, kg0.z, kg0.w, kg1.x, kg1.y, kg1.z, kg1.w};
    for (int m = gw; m < T; m += NGW) {
        const bf16* src = F.QKV + (size_t)m * QKVD;
        v4u raw[6];
#pragma unroll
        for (int j = 0; j < 6; ++j) raw[j] = *(const v4u*)(src + (F.lane + 64 * j) * 8);
        const bool lat = m >= TC;
        float cs[8], sn[8];
        int b = 0, p = 0;
        if (lat) { b = (m - TC) >> 12; p = (m - TC) & 4095; const int pos = (c16 < 8) ? (p >> 6) : (p & 63); const float* rc = F.rope + pos * 32 + 8 * (c16 & 3);
            const f32x4 c0 = *(const f32x4*)rc, c1 = *(const f32x4*)(rc + 4), s0 = *(const f32x4*)(rc + 2048), s1 = *(const f32x4*)(rc + 2048 + 4);
            cs[0] = c0.x; cs[1] = c0.y; cs[2] = c0.z; cs[3] = c0.w; cs[4] = c1.x; cs[5] = c1.y; cs[6] = c1.z; cs[7] = c1.w;
            sn[0] = s0.x; sn[1] = s0.y; sn[2] = s0.z; sn[3] = s0.w; sn[4] = s1.x; sn[5] = s1.y; sn[6] = s1.z; sn[7] = s1.w; }
        const bool second = (c16 & 4) != 0;
#pragma unroll
        for (int j = 0; j < 6; ++j) {
            float x[8] = {bf_lo(raw[j].x), bf_hi(raw[j].x), bf_lo(raw[j].y), bf_hi(raw[j].y), bf_lo(raw[j].z), bf_hi(raw[j].z), bf_lo(raw[j].w), bf_hi(raw[j].w)};
            if (j < 5) {
                float ss = 0.f;
#pragma unroll
                for (int e = 0; e < 8; ++e) ss += x[e] * x[e];
                ss += swz_xor<1>(ss); ss += swz_xor<2>(ss); ss += swz_xor<4>(ss); ss += swz_xor<8>(ss);
                const float rinv = 1.0f / sqrtf(ss * (1.0f / HD) + QK_EPS);
#pragma unroll
                for (int e = 0; e < 8; ++e) x[e] = x[e] * rinv * (j < 4 ? qg[e] : kg[e]);
                if (lat) {
#pragma unroll
                    for (int e = 0; e < 8; ++e) { const float o = swz_xor<4>(x[e]); x[e] = second ? (o * sn[e] + x[e] * cs[e]) : (x[e] * cs[e] - o * sn[e]); }
                }
            }
            v4u w; w.x = cvt_pk_bf16(x[0], x[1]); w.y = cvt_pk_bf16(x[2], x[3]); w.z = cvt_pk_bf16(x[4], x[5]); w.w = cvt_pk_bf16(x[6], x[7]);
            if (j < 4) { *(v4u*)(F.Q + (size_t)m * D + (4 * j + hq) * HD + 8 * c16) = w; }
            else {
                const int col = hq * HD + 8 * c16;
                if (lat) { bf16* dst = (j == 4 ? F.KALL : F.VALL) + ((size_t)b * KVLEN + PAST + p) * DKV + col; *(v4u*)dst = w; }
                else { bf16* dst = (j == 4 ? F.KCTX : F.VCTX) + (size_t)m * DKV + col; *(v4u*)dst = w;
                    float* fo = (j == 4 ? F.ctxk : F.ctxv) + (size_t)m * DKV + col;
                    *(f32x4*)fo = (f32x4){x[0], x[1], x[2], x[3]}; *(f32x4*)(fo + 4) = (f32x4){x[4], x[5], x[6], x[7]}; }
            }
        }
    }
}

__device__ __forceinline__ void pool_phase(const int wv, int modidx  ) {
    Frame F = fresh_frame(wv);
    const float* modv = F.mod + modidx;
    const int gw = F.vcu * NWAVES + F.wave, NGW = F.G * NWAVES;
    const int per = (T + NGW - 1) / NGW;
    f32x4 sc1[8]; int cur_bi = -1;
    for (int m = gw * per; m < (gw + 1) * per && m < T; ++m) {
        const int bi = batch_of_row(m);
        if (bi != cur_bi) { cur_bi = bi; const float* mv = modv + (size_t)bi * MODW + D;
#pragma unroll
            for (int j = 0; j < 8; ++j) sc1[j] = *(const f32x4*)(mv + 256 * j + 4 * F.lane) + 1.0f; }
        int s0, n;
        if (m < TC) { s0 = m & ~(CSEQ - 1); n = CSEQ; } else { s0 = TC + ((m - TC) & ~(LSEQ - 1)); n = LSEQ; }
        const int t = m - s0;
        bf16* dp = F.DP + (size_t)m * D;
#pragma unroll
        for (int j = 0; j < 8; ++j) {
            const int half = 1 << (j >> 1);
            const int lo = t - half < 0 ? 0 : t - half, hi = t + half > n ? n : t + half;
            f32x4 acc = (f32x4){0.f, 0.f, 0.f, 0.f};
            for (int r = lo; r < hi; ++r) acc += *(const f32x4*)(F.X + (size_t)(s0 + r) * D + 256 * j + 4 * F.lane);
            const f32x4 self = *(const f32x4*)(F.X + (size_t)m * D + 256 * j + 4 * F.lane);
            const f32x4 d = (acc * (1.0f / (float)(hi - lo)) - self) * sc1[j];
            v2u w; w.x = cvt_pk_bf16(d.x, d.y); w.y = cvt_pk_bf16(d.z, d.w); *(v2u*)(dp + 256 * j + 4 * F.lane) = w;
        }
    }
}

__device__ __forceinline__ void grid_barrier() {
    KArgs ka = (KArgs)__builtin_amdgcn_kernarg_segment_ptr();
    asm volatile("" : "+s"(ka));
    XcdBarrier b; b.bar = (unsigned*)(ka->ws + WS_CTL) + CW_BAR; b.x = xb_xcc_id(); b.st = (volatile LAS unsigned*)((LAS unsigned char*)g_lds + MISC_OFF) + 8;
    xcd_barrier(b);
}
__device__ __forceinline__ void attention_phase(const int wv) {
    Frame F = fresh_frame(wv);
    const int x = F.vcu >> 5, cc = F.vcu & 31;
    for (int i = 0; i < 8; ++i) {
        const int pair = x * 4 + (i >> 1), uu = (i & 1) * 32 + cc, b = pair >> 2, kvh = pair & 3, h = kvh * 4 + (uu >> 4), qb = uu & 15;
        const size_t qoff = ((size_t)TC + (size_t)b * LSEQ + (size_t)qb * 256) * D + h * HD;
        att::attn_dense_body(F.Q + qoff, F.KALL + (size_t)b * KVLEN * DKV + kvh * HD, F.VALL + (size_t)b * KVLEN * DKV + kvh * HD, F.Q + qoff, KVLEN, (char*)g_lds, wv);
        __syncthreads(); }
    for (int i = 0; i < 2; ++i) {
        const int uu = i * 32 + cc, pair = x * 16 + (uu >> 2), b = pair >> 2, kvh = pair & 3, h = kvh * 4 + (uu & 3);
        const size_t qoff = (size_t)b * CSEQ * D + h * HD;
        att::attn_dense_body(F.Q + qoff, F.KCTX + (size_t)b * CSEQ * DKV + kvh * HD, F.VCTX + (size_t)b * CSEQ * DKV + kvh * HD, F.Q + qoff, CSEQ, (char*)g_lds, wv);
        __syncthreads(); }
}
__device__ __forceinline__ int mod_off(int l, int sub, int k) { return l * NB * MODW + (sub * 3 + k) * D; }

__global__ void __launch_bounds__(NWAVES * 64, 2) fwd_kernel(Args args) {
    { volatile LAS unsigned* MISC = (volatile LAS unsigned*)((LAS unsigned char*)g_lds + MISC_OFF);
      for (int u = threadIdx.x; u < 32; u += NWAVES * 64) MISC[u] = 0u;
      __syncthreads();
      (void)xcd_barrier_post((unsigned*)(args.ws + WS_CTL) + CW_BAR, MISC + 8); }
    PG8_LAS unsigned char* ring = (PG8_LAS unsigned char*)g_lds;
    int wv = __builtin_amdgcn_readfirstlane(threadIdx.x >> 6); asm volatile("" : "+s"(wv));

    p0_prologue(wv);
    grid_barrier();
    row_phase<0, 2>(wv, 0, mod_off(0, 0, 0));
    grid_barrier();

    for (int l = 0; l < 2; ++l) {
        for (int s = 0; s < 2; ++s) {
            const int f = l * 2 + s, sub = s * 2;
            { Frame F = fresh_frame(wv);
              pg8::Gemm g{F.H, F.W13 + (size_t)f * 2 * FF * D, T, 2 * FF, D, D, 0}; pg8::StaticOrder S; S.init(T, 2 * FF, F.G, (int)blockIdx.x);
              pg8::EpiSwiGLU E{F.Gb, FF};
              pg8::gemm_phase<pg8::EpiSwiGLU, true>(ring, g, S, E, wv); }
            grid_barrier();
            { Frame F = fresh_frame(wv);
              pg8::Gemm g{F.Gb, F.W2 + (size_t)f * D * FF, T, D, FF, FF, 0}; pg8::StaticOrder S; S.init(T, D, F.G, (int)blockIdx.x);
              pg8::EpiResid E{F.X, D, F.mod + mod_off(l, sub, 2), MODW, 0.5f / (SC_G * SC_W2), nullptr};
              pg8::gemm_phase<pg8::EpiResid, true>(ring, g, S, E, wv); }
            grid_barrier();
            if (s == 0) { if (l == 0) row_phase<1, 1>(wv, l * 3 + sub, mod_off(0, 1, 0)); else row_phase<1, 0>(wv, l * 3 + sub, 0); }
            else { if (l == 0) row_phase<1, 2>(wv, l * 3 + sub, mod_off(1, 0, 0)); else row_phase<1, 0>(wv, l * 3 + sub, 0); }
            grid_barrier();
            if (s == 0) {
                if (l == 0) {
                    { Frame F = fresh_frame(wv);
                      pg8::Gemm g{F.H, F.Wqkv, T, QKVD, D * 2, D * 2, 0}; pg8::StaticOrder S; S.init(T, QKVD, F.G, (int)blockIdx.x);
                      pg8::EpiBf16 E{F.QKV, QKVD};
                      pg8::gemm_phase<pg8::EpiBf16, false>(ring, g, S, E, wv); }
                    grid_barrier();
                    qkv_post(wv);
                    grid_barrier();
                    attention_phase(wv);
                    grid_barrier();
                    { Frame F = fresh_frame(wv);
                      pg8::Gemm g{F.Q, F.Wo, T, D, D * 2, D * 2, 0}; pg8::StaticOrder S; S.init(T, D, F.G, (int)blockIdx.x);
                      pg8::EpiResid E{F.X, D, F.mod + mod_off(0, 1, 2), MODW, 1.0f, nullptr};
                      pg8::gemm_phase<pg8::EpiResid, false>(ring, g, S, E, wv); }
                    grid_barrier();
                } else {
                    pool_phase(wv, mod_off(1, 1, 0));
                    grid_barrier();
                    { Frame F = fresh_frame(wv);
                      pg8::Gemm g{F.DP, F.Wpool, T, D, 512 * 2, D * 2, 1}; pg8::StaticOrder S; S.init(T, D, F.G, (int)blockIdx.x);
                      pg8::EpiResid E{F.X, D, F.mod + mod_off(1, 1, 2), MODW, 1.0f, F.pool_scale};
                      pg8::gemm_phase<pg8::EpiResid, false>(ring, g, S, E, wv); }
                    grid_barrier();
                }
                row_phase<1, 2>(wv, l * 3 + 1, mod_off(l, 2, 0));
                grid_barrier();
            }
        }
    }
}

extern "C" void kernel_launch(void* const* d_in, const int* in_sizes, int n_in, void* d_out, int out_size, void* d_ws, size_t ws_size, hipStream_t stream) {
    static int grid = 0;
    if (grid == 0) {
        if (n_in != 19 || ws_size < WS_END) { fprintf(stderr, "kernel_launch: n_in %d ws %zu (need %zu)\n", n_in, ws_size, (size_t)WS_END); grid = -1; return; }
        int dev = 0, cus = 0;
        if (hipGetDevice(&dev) != hipSuccess || hipDeviceGetAttribute(&cus, hipDeviceAttributeMultiprocessorCount, dev) != hipSuccess) { grid = -1; return; }
        if (hipFuncSetAttribute((const void*)fwd_kernel, hipFuncAttributeMaxDynamicSharedMemorySize, LDS_BYTES) != hipSuccess) { fprintf(stderr, "kernel_launch: hipFuncSetAttribute failed\n"); grid = -1; return; }
        int per_cu = 0;
        if (hipOccupancyMaxActiveBlocksPerMultiprocessor(&per_cu, (const void*)fwd_kernel, NWAVES * 64, LDS_BYTES) != hipSuccess || per_cu < 1) fprintf(stderr, "kernel_launch: occupancy query says %d\n", per_cu);
        (void)hipGetLastError();
        grid = cus;
    }
    if (grid < 0) return;
    (void)hipMemsetAsync((char*)d_ws + WS_CTL, 0, CTL_ZERO_BYTES, stream);
    Args a{};
    for (int i = 0; i < 19; ++i) a.in[i] = (const float*)d_in[i];
    a.out = (float*)d_out; a.ws = (unsigned char*)d_ws;
    hipLaunchKernelGGL(fwd_kernel, dim3(grid), dim3(NWAVES * 64), LDS_BYTES, stream, a);
}
```
